# Optimizing an MI355X kernel written in HIP

```python
import jax, jax.numpy as jnp
from jax import lax
import numpy as np

D_MODEL = 1024
BATCH = 2
SEQ = 16384
DEPTH = 1
DEC_BATCH = 16
DEC_SEQ = 32
PAST_LEN = 2048

CHUNK = 64
GLA_HEADS = 4
GLA_DK = 64
GLA_DV = 128
GLA_RANK = 16
GLA_TAU = 16.0
GLA_QK = GLA_HEADS * GLA_DK
GLA_V = GLA_HEADS * GLA_DV
FOX_HEADS = 8
FOX_DH = 64
FOX_W = FOX_HEADS * FOX_DH
Q_BLOCK = 128
D_FF = ((8 * D_MODEL) // 3 + 255) // 256 * 256
DN_ALPHA = (2.0 * DEPTH) ** 0.25
DN_BETA = (8.0 * DEPTH) ** -0.25
LN_EPS = 1e-5
RMS_EPS = 1e-5
SPLIT_SIZES = (GLA_QK, GLA_QK, GLA_V, GLA_RANK, GLA_V, FOX_W, FOX_W, FOX_W, FOX_HEADS, D_MODEL, D_MODEL)
D_IN = sum(SPLIT_SIZES)
VALUE_SPLITS = (2, 7)

kernel_name = "gla_fox_deepnorm_streaming_encoder_step"


def _split_points():
    return [int(i) for i in np.cumsum(SPLIT_SIZES)[:-1]]


def layer_norm(x, g, b):
    xf = x.astype(jnp.float32)
    mu = jnp.mean(xf, axis=-1, keepdims=True)
    var = jnp.mean(jnp.square(xf - mu), axis=-1, keepdims=True)
    return ((xf - mu) * lax.rsqrt(var + LN_EPS)).astype(x.dtype) * g + b


def gla_block(S, xs):
    q, k, v, la = xs
    L = q.shape[1]
    b = jnp.cumsum(la, axis=1)
    causal = jnp.tril(jnp.ones((L, L), dtype=bool))
    rel = b[:, :, None] - b[:, None, :]
    decay = jnp.exp(jnp.where(causal[None, :, :, None, None], rel, -jnp.inf))
    A = jnp.einsum('bthd,bshd,btshd->bhts', q.astype(jnp.float32), k.astype(jnp.float32), decay)
    intra = jnp.einsum('bhts,bshv->bthv', A, v.astype(jnp.float32))
    inter = jnp.einsum('bthd,bhdv->bthv', q * jnp.exp(b), S)
    b_last = b[:, -1]
    k_dec = k * jnp.exp(b_last[:, None] - b)
    S_new = jnp.exp(b_last)[..., None] * S + jnp.einsum('bshd,bshv->bhdv', k_dec, v.astype(jnp.float32))
    return S_new, inter + intra


def gla_scan(S0, q, k, v, la):
    B, L = q.shape[0], q.shape[1]
    c = min(CHUNK, L)
    nc = L // c

    def to_blocks(t):
        return jnp.moveaxis(t.reshape((B, nc, c) + t.shape[2:]), 1, 0)

    S_final, o = lax.scan(gla_block, S0.astype(jnp.float32),
                          (to_blocks(q), to_blocks(k), to_blocks(v), to_blocks(la)))
    o = jnp.moveaxis(o, 0, 1).reshape(B, L, GLA_HEADS, GLA_DV)
    return S_final, o


def fox_attention(q, k, v, c_q, c_k, q_pos, k_pos):
    B, Lq, H, Dh = q.shape
    bs = min(Q_BLOCK, Lq)
    nb = Lq // bs
    scale = Dh ** -0.5
    qb = jnp.moveaxis(q.reshape(B, nb, bs, H, Dh), 1, 0)
    cb = jnp.moveaxis(c_q.reshape(B, nb, bs, H), 1, 0)
    pb = q_pos.reshape(nb, bs)
    ck_h = jnp.swapaxes(c_k, 1, 2)

    def one_block(args):
        qi, ci, pi = args
        s = jnp.einsum('bqhd,bkhd->bhqk', qi, k).astype(jnp.float32) * scale
        s = s + jnp.swapaxes(ci, 1, 2)[..., None] - ck_h[:, :, None, :]
        s = jnp.where((pi[:, None] >= k_pos[None, :])[None, None], s, -jnp.inf)
        p = jax.nn.softmax(s, axis=-1)
        return jnp.einsum('bhqk,bkhd->bqhd', p.astype(v.dtype), v)

    o = lax.map(one_block, (qb, cb, pb))
    return jnp.moveaxis(o, 0, 1).reshape(B, Lq, H, Dh)


def hybrid_layer(x, gla_s0, fox_k_past, fox_v_past, fox_lf_past,
                 w_in, b_in, w_alpha2, b_alpha2, gla_norm_g, w_proj_gla, w_proj_fox, w_out,
                 ln1_g, ln1_b, w_ffn_gate, w_ffn_up, w_ffn_down, ln2_g, ln2_b):
    B, L, _ = x.shape
    h = x @ w_in + b_in
    gq, gk, gv, ga, gr, fq, fk, fv, ff, zg, zf = jnp.split(h, _split_points(), axis=-1)

    gq = gq.reshape(B, L, GLA_HEADS, GLA_DK) * (GLA_DK ** -0.5)
    gk = gk.reshape(B, L, GLA_HEADS, GLA_DK)
    gv = gv.reshape(B, L, GLA_HEADS, GLA_DV)
    la = jax.nn.log_sigmoid((ga @ w_alpha2 + b_alpha2).astype(jnp.float32)) / GLA_TAU
    la = la.reshape(B, L, GLA_HEADS, GLA_DK)
    gla_state, o = gla_scan(gla_s0, gq, gk, gv, la)
    o = o * lax.rsqrt(jnp.mean(jnp.square(o), axis=-1, keepdims=True) + RMS_EPS)
    o = o.reshape(B, L, GLA_V) * gla_norm_g * jax.nn.silu(gr.astype(jnp.float32))
    y_gla = o.astype(x.dtype) @ w_proj_gla

    fq = fq.reshape(B, L, FOX_HEADS, FOX_DH)
    fk = fk.reshape(B, L, FOX_HEADS, FOX_DH)
    fv = fv.reshape(B, L, FOX_HEADS, FOX_DH)
    lf = jax.nn.log_sigmoid(ff.astype(jnp.float32))
    if fox_k_past is None:
        k_all, v_all, lf_all = fk, fv, lf
    else:
        k_all = jnp.concatenate([fox_k_past.astype(fk.dtype), fk], axis=1)
        v_all = jnp.concatenate([fox_v_past.astype(fv.dtype), fv], axis=1)
        lf_all = jnp.concatenate([fox_lf_past.astype(jnp.float32), lf], axis=1)
    Lk = k_all.shape[1]
    past = Lk - L
    c_all = jnp.cumsum(lf_all, axis=1)
    o_f = fox_attention(fq, k_all, v_all, c_all[:, past:], c_all,
                        past + jnp.arange(L), jnp.arange(Lk))
    y_fox = o_f.reshape(B, L, FOX_W) @ w_proj_fox

    m = jax.nn.sigmoid(zg) * y_gla + jax.nn.sigmoid(zf) * y_fox
    x1 = layer_norm(DN_ALPHA * x + m @ w_out, ln1_g, ln1_b)

    f = (jax.nn.silu(x1 @ w_ffn_gate) * (x1 @ w_ffn_up)) @ w_ffn_down
    x2 = layer_norm(DN_ALPHA * x1 + f, ln2_g, ln2_b)
    return x2, gla_state, fk, fv, lf


def setup_inputs(seed: int = 0) -> dict:
    key = jax.random.key(seed)
    ks = jax.random.split(key, 24)
    nrm = jax.random.normal
    f32 = jnp.float32
    col_scale = np.concatenate([np.full((n,), DN_BETA if i in VALUE_SPLITS else 1.0, np.float32)
                                for i, n in enumerate(SPLIT_SIZES)])
    return {
        "x_prompt": nrm(ks[0], (BATCH, SEQ, D_MODEL), f32),
        "x_sample": nrm(ks[1], (DEC_BATCH, DEC_SEQ, D_MODEL), f32),
        "state_gla": 2.0 * nrm(ks[2], (DEPTH, DEC_BATCH, GLA_HEADS, GLA_DK, GLA_DV), f32),
        "cache_fox_k": nrm(ks[3], (DEPTH, DEC_BATCH, PAST_LEN, FOX_HEADS, FOX_DH), f32),
        "cache_fox_v": DN_BETA * nrm(ks[4], (DEPTH, DEC_BATCH, PAST_LEN, FOX_HEADS, FOX_DH), f32),
        "cache_fox_logf": jax.nn.log_sigmoid(nrm(ks[5], (DEPTH, DEC_BATCH, PAST_LEN, FOX_HEADS), f32)),
        "w_in": nrm(ks[6], (DEPTH, D_MODEL, D_IN), f32) * (D_MODEL ** -0.5) * jnp.asarray(col_scale),
        "b_in": 0.02 * nrm(ks[7], (DEPTH, D_IN), f32),
        "w_alpha2": nrm(ks[8], (DEPTH, GLA_RANK, GLA_QK), f32) * (GLA_RANK ** -0.5),
        "b_alpha2": 0.02 * nrm(ks[9], (DEPTH, GLA_QK), f32),
        "gla_norm_g": 1.0 + 0.02 * nrm(ks[10], (DEPTH, GLA_V), f32),
        "w_proj_gla": nrm(ks[11], (DEPTH, GLA_V, D_MODEL), f32) * (GLA_V ** -0.5),
        "w_proj_fox": nrm(ks[12], (DEPTH, FOX_W, D_MODEL), f32) * (FOX_W ** -0.5),
        "w_out": nrm(ks[13], (DEPTH, D_MODEL, D_MODEL), f32) * (D_MODEL ** -0.5) * DN_BETA,
        "ln1_g": 1.0 + 0.02 * nrm(ks[14], (DEPTH, D_MODEL), f32),
        "ln1_b": 0.02 * nrm(ks[15], (DEPTH, D_MODEL), f32),
        "w_ffn_gate": nrm(ks[16], (DEPTH, D_MODEL, D_FF), f32) * (D_MODEL ** -0.5) * DN_BETA,
        "w_ffn_up": nrm(ks[17], (DEPTH, D_MODEL, D_FF), f32) * (D_MODEL ** -0.5) * DN_BETA,
        "w_ffn_down": nrm(ks[18], (DEPTH, D_FF, D_MODEL), f32) * (D_FF ** -0.5) * DN_BETA,
        "ln2_g": 1.0 + 0.02 * nrm(ks[19], (DEPTH, D_MODEL), f32),
        "ln2_b": 0.02 * nrm(ks[20], (DEPTH, D_MODEL), f32),
    }


def reference(x_prompt, x_sample, state_gla, cache_fox_k, cache_fox_v, cache_fox_logf,
              w_in, b_in, w_alpha2, b_alpha2, gla_norm_g, w_proj_gla, w_proj_fox, w_out,
              ln1_g, ln1_b, w_ffn_gate, w_ffn_up, w_ffn_down, ln2_g, ln2_b):
    yp, ys = x_prompt, x_sample
    p_gla, p_k, p_v, p_lf = [], [], [], []
    s_gla, s_k, s_v, s_lf = [], [], [], []
    for l in range(DEPTH):
        w = (w_in[l], b_in[l], w_alpha2[l], b_alpha2[l], gla_norm_g[l], w_proj_gla[l], w_proj_fox[l],
             w_out[l], ln1_g[l], ln1_b[l], w_ffn_gate[l], w_ffn_up[l], w_ffn_down[l], ln2_g[l], ln2_b[l])
        s0 = jnp.zeros((yp.shape[0], GLA_HEADS, GLA_DK, GLA_DV), jnp.float32)
        yp, g1, k1, v1, lf1 = hybrid_layer(yp, s0, None, None, None, *w)
        p_gla.append(g1); p_k.append(k1); p_v.append(v1); p_lf.append(lf1)
        ys, g2, k2, v2, lf2 = hybrid_layer(ys, state_gla[l], cache_fox_k[l], cache_fox_v[l],
                                           cache_fox_logf[l], *w)
        s_gla.append(g2); s_k.append(k2); s_v.append(v2); s_lf.append(lf2)
    return (yp, ys,
            jnp.stack(p_gla), jnp.stack(p_k), jnp.stack(p_v), jnp.stack(p_lf),
            jnp.stack(s_gla), jnp.stack(s_k), jnp.stack(s_v), jnp.stack(s_lf))
```

```cpp
#include <hip/hip_runtime.h>
#include <hip/hip_cooperative_groups.h>
#include <cstdio>
#include <cstdint>
namespace cg = cooperative_groups;

#define LAS __attribute__((address_space(3)))
typedef unsigned short bf16_t;
typedef short bf16x8 __attribute__((ext_vector_type(8)));
typedef short s16x4 __attribute__((ext_vector_type(4)));
typedef float f32x4 __attribute__((ext_vector_type(4)));
typedef float f32x2 __attribute__((ext_vector_type(2)));
typedef unsigned u32x4 __attribute__((ext_vector_type(4)));
typedef unsigned u32x2 __attribute__((ext_vector_type(2)));
typedef __bf16 bf16x2_t __attribute__((ext_vector_type(2)));

constexpr int MP = 32768, MS = 512, MT = 33280, DM = 1024, DFF = 2816;
constexpr int NIN = 5376;
constexpr float DN_ALPHA = 1.189207115002721f;
constexpr float LOG2E = 1.4426950408889634f;
constexpr float C2 = 0.125f * LOG2E;
constexpr float THR2 = 60.0f;
constexpr size_t O_Y = 0;
constexpr size_t O_GSP = (size_t)MT * 1024;
constexpr size_t O_FKP = O_GSP + 65536;
constexpr size_t O_FVP = O_FKP + (size_t)MP * 512;
constexpr size_t O_LFP = O_FVP + (size_t)MP * 512;
constexpr size_t O_GSS = O_LFP + (size_t)MP * 8;
constexpr size_t O_FKS = O_GSS + 524288;
constexpr size_t O_FVS = O_FKS + 262144;
constexpr size_t O_LFS = O_FVS + 262144;
constexpr size_t MiB = 1u << 20;
constexpr size_t WS_CTL = 0, CTL_BYTES = 1 * MiB;
constexpr size_t WS_VEC = 1 * MiB;
constexpr size_t WS_WIN = 2 * MiB, WS_WP = 13 * MiB, WS_WO = 15 * MiB, WS_WGU = 17 * MiB, WS_WD = 28 * MiB;
constexpr size_t WS_GA = 34 * MiB, WS_STP1 = 37 * MiB, WS_STP2 = 42 * MiB, WS_FST1 = 47 * MiB;
constexpr size_t WS_CLOC = 48 * MiB, WS_CTOT = 57 * MiB, WS_DEC = 58 * MiB;
constexpr size_t WS_R1 = 60 * MiB;
constexpr size_t WS_R2 = 127 * MiB;
constexpr size_t WS_GQ = WS_R2, WS_GK = WS_GQ + (size_t)MT * 256 * 2, WS_GV = WS_GK + (size_t)MT * 256 * 2;
constexpr size_t WS_R3 = 192 * MiB;
constexpr size_t WS_GR = WS_R3, WS_FQ = WS_GR + (size_t)MT * 512 * 2, WS_FK = WS_FQ + (size_t)MT * 512 * 2, WS_FV = WS_FK + (size_t)MT * 512 * 2, WS_OGF = WS_FV + (size_t)MT * 512 * 2;
constexpr size_t WS_R4 = 387 * MiB;
constexpr size_t WS_END = 419 * MiB;
constexpr int CW_ACTR = 0;
constexpr int CW_QMAX = 64;
constexpr int CW_KBLK = 4096;
constexpr int VO_BIAS = 0, VO_GW = 5376, VO_BW = 5376 + 5632, VO_BWP = 5376 + 2 * 5632;

constexpr int LDS_BYTES = 131072 + 1024;

__device__ __forceinline__ unsigned pk2(float lo, float hi) { f32x2 v = {lo, hi}; bf16x2_t b = __builtin_convertvector(v, bf16x2_t); return __builtin_bit_cast(unsigned, b); }
__device__ __forceinline__ float bflo(unsigned w) { return __uint_as_float(w << 16); }
__device__ __forceinline__ float bfhi(unsigned w) { return __uint_as_float(w & 0xffff0000u); }
__device__ __forceinline__ float sigmoidf_(float x) { return __builtin_amdgcn_rcpf(1.0f + __expf(-x)); }
__device__ __forceinline__ float siluf_(float x) { return x * __builtin_amdgcn_rcpf(1.0f + __expf(-x)); }
__device__ __forceinline__ float logsigf_(float z) { return fminf(z, 0.f) - __logf(1.0f + __expf(-fabsf(z))); }
__device__ __forceinline__ float wave_incl_scan(float v, int lane) {
#pragma unroll
    for (int o = 1; o < 64; o <<= 1) { float t = __shfl_up(v, o); if (lane >= o) v += t; }
    return v;
}
__device__ __forceinline__ bf16x8 tr_read2(const LAS unsigned char* p0, const LAS unsigned char* p1) {
    s16x4 a = __builtin_bit_cast(s16x4, __builtin_amdgcn_ds_read_tr16_b64_v4i16((LAS s16x4*)p0));
    s16x4 b = __builtin_bit_cast(s16x4, __builtin_amdgcn_ds_read_tr16_b64_v4i16((LAS s16x4*)p1));
    return (bf16x8){a[0], a[1], a[2], a[3], b[0], b[1], b[2], b[3]};
}
__device__ __forceinline__ bf16x8 pack8(f32x4 a, f32x4 b) {
    u32x4 w; w.x = pk2(a[0], a[1]); w.y = pk2(a[2], a[3]); w.z = pk2(b[0], b[1]); w.w = pk2(b[2], b[3]);
    return __builtin_bit_cast(bf16x8, w);
}

struct Params {
    const float* in[21];
    float* out;
    unsigned char* ws;
};


typedef __attribute__((address_space(4))) const unsigned char* kptr_t;
__device__ __forceinline__ kptr_t kargs_() { kptr_t k = (kptr_t)__builtin_amdgcn_kernarg_segment_ptr(); asm volatile("" : "+s"(k)); return k; }
typedef const float* cfptr_t; typedef float* fptr_t; typedef unsigned char* ucptr_t;
#define PIN(i) (*(const __attribute__((address_space(4))) cfptr_t*)(kargs_() + 8 * (i)))
#define POUT() (*(const __attribute__((address_space(4))) fptr_t*)(kargs_() + 8 * 21))
#define PWS() (*(const __attribute__((address_space(4))) ucptr_t*)(kargs_() + 8 * 22))

namespace pg8 {
constexpr int BM = 256, BK = 64, HALF = 128, HTB = HALF * BK * 2, STAGE_BYTES = 8 * HTB, NXCD = 8, WGM = 8;
__host__ __device__ __forceinline__ int lds_byte(int r, int c) { const int st = (r >> 4) * 2 + (c >> 5), rr = r & 15, cc = c & 31, ob = rr * 64 + cc * 2; return st * 1024 + (ob ^ (((ob >> 9) & 1) << 5)); }
__host__ __device__ __forceinline__ void stage_rc(int b, int& R, int& C) { const int st = b / 1024, sb = b % 1024, swz = sb ^ (((sb >> 9) & 1) << 5); R = (st >> 1) * 16 + swz / 64; C = (st & 1) * 32 + (swz % 64) / 2; }
__host__ __device__ __forceinline__ int perm32(int rho) { const int n = rho >> 4, i = rho & 15; return 8 * (i >> 2) + 4 * n + (i & 3); }
struct Unit { int pm, pn, pz; };
struct Gemm { const bf16_t* A; const bf16_t* Bt; int M, N, K, lda, ldb; const bf16_t* A2; const bf16_t* Bt2; };
struct StaticOrder {
    int nM, nN, nwg, G, c, zs;
    __host__ __device__ void init(int M, int N, int G_, int c_, int zs_ = 0) { nM = M / BM; nN = N / BM; nwg = nM * nN; G = G_; c = c_; zs = zs_; }
    __host__ __device__ bool next(int i, Unit& u) const {
        u.pz = zs ? (i & 1) : 0; if (zs) i >>= 1;
        const long L = (long)i * G + c; if (L >= nwg) return false;
        int wgid = (int)L; { const int q = nwg / NXCD, r = nwg % NXCD, xcd = wgid % NXCD, off = wgid / NXCD; wgid = (xcd < r ? xcd * (q + 1) : r * (q + 1) + (xcd - r) * q) + off; }
        const int nig = WGM * nN, gid = wgid / nig, fm = gid * WGM, gsz = (nM - fm) < WGM ? (nM - fm) : WGM;
        u.pm = fm + ((wgid % nig) % gsz); u.pn = (wgid % nig) / gsz; return true;
    }
};
template <class Epi>
__device__ __forceinline__ void gemm_phase(LAS unsigned char* lds, const Gemm g, const StaticOrder& S, const Epi& E) {
    int tid = threadIdx.x; asm volatile("" : "+v"(tid));
    const int wid = __builtin_amdgcn_readfirstlane(tid >> 6), lane = tid & 63, wr = wid >> 2, wc = wid & 3, fr = lane & 15, fq = lane >> 4;
    const int K = g.K, nt = K / BK;
    unsigned voffA[2], voffB[2];
#pragma unroll
    for (int i = 0; i < 2; ++i) { int R, C; stage_rc(tid * 16 + i * 8192, R, C); const int Rb = (R & ~31) + perm32(R & 31);
        voffA[i] = (unsigned)(R * g.lda + C) * 2u; voffB[i] = (unsigned)(Rb * g.ldb + C) * 2u; }
    const size_t kstep = (size_t)(BK * 2);
    const size_t hstepA = (size_t)HALF * g.lda * 2, hstepB = (size_t)HALF * g.ldb * 2;
    const size_t tstepA = 2 * hstepA, tstepB = 2 * hstepB;
    const unsigned ldsw = (unsigned)wid * 1024u;
    const int aoff = lds_byte(wr * 64 + fr, fq * 8), boff = lds_byte(wc * 32 + fr, fq * 8);
#define PG8_SA(b, h) (((b) * 2 + (h)) * HTB)
#define PG8_SB(b, h) ((4 + (b) * 2 + (h)) * HTB)
#define PG8_STAGE(bufoff, gbase, voff) do { _Pragma("unroll") for (int _i = 0; _i < 2; ++_i) \
        __builtin_amdgcn_global_load_lds((const unsigned*)((const char*)(gbase) + (voff)[_i]), (LAS unsigned*)(lds + (bufoff) + ldsw + _i * 8192), 16, 0, 0); } while (0)
#define PG8_LDA(dst, b, h) do { _Pragma("unroll") for (int m = 0; m < 4; ++m) _Pragma("unroll") for (int k = 0; k < 2; ++k) dst[m][k] = *(const LAS bf16x8*)(lds + PG8_SA(b, h) + aoff + m * 2048 + k * 1024); } while (0)
#define PG8_LDB(dst, b, h) do { _Pragma("unroll") for (int n = 0; n < 2; ++n) _Pragma("unroll") for (int k = 0; k < 2; ++k) dst[n][k] = *(const LAS bf16x8*)(lds + PG8_SB(b, h) + boff + n * 2048 + k * 1024); } while (0)
#define PG8_MMA(ai, bj, At, Bt) do { __builtin_amdgcn_s_setprio(1); _Pragma("unroll") for (int m = 0; m < 4; ++m) _Pragma("unroll") for (int n = 0; n < 2; ++n) _Pragma("unroll") for (int k = 0; k < 2; ++k) \
        acc[ai][bj][m][n] = __builtin_amdgcn_mfma_f32_16x16x32_bf16(Bt[n][k], At[m][k], acc[ai][bj][m][n], 0, 0, 0); __builtin_amdgcn_s_setprio(0); } while (0)
#define PG8_WAIT_V(n) asm volatile("s_waitcnt vmcnt(" #n ")" ::: "memory")
#define PG8_WAIT_L(n) asm volatile("s_waitcnt lgkmcnt(" #n ")" ::: "memory")
#define PG8_BAR __builtin_amdgcn_s_barrier()
#define PG8_SCHED __builtin_amdgcn_sched_barrier(0)
    Unit cur, nxt; int ui = 0;
    if (!S.next(0, cur)) return;
    f32x4 acc[2][2][4][2];
#pragma unroll
    for (int a = 0; a < 2; ++a)
#pragma unroll
        for (int b = 0; b < 2; ++b)
#pragma unroll
            for (int m = 0; m < 4; ++m)
#pragma unroll
                for (int n = 0; n < 2; ++n) acc[a][b][m][n] = (f32x4){0.f, 0.f, 0.f, 0.f};
    bf16x8 At[4][2], B0[2][2], B1[2][2];
    const char* cA = (const char*)(cur.pz ? g.A2 : g.A) + (size_t)cur.pm * tstepA; const char* cB = (const char*)(cur.pz ? g.Bt2 : g.Bt) + (size_t)cur.pn * tstepB;
    {
        PG8_STAGE(PG8_SB(0, 0), cB, voffB); PG8_STAGE(PG8_SB(0, 1), cB + hstepB, voffB); PG8_STAGE(PG8_SA(0, 0), cA, voffA); PG8_STAGE(PG8_SA(0, 1), cA + hstepA, voffA);
        if (wr == 1) PG8_BAR;
        PG8_WAIT_V(2); PG8_BAR;
        PG8_STAGE(PG8_SB(1, 0), cB + kstep, voffB); PG8_STAGE(PG8_SA(1, 0), cA + kstep, voffA); PG8_STAGE(PG8_SB(1, 1), cB + hstepB + kstep, voffB);
        PG8_WAIT_V(6); PG8_BAR;
    }
    for (;;) {
        const bool has_next = S.next(ui + 1, nxt);
        const char* nA = has_next ? (const char*)(nxt.pz ? g.A2 : g.A) + (size_t)nxt.pm * tstepA : cA; const char* nB = has_next ? (const char*)(nxt.pz ? g.Bt2 : g.Bt) + (size_t)nxt.pn * tstepB : cB;
        for (int t = 0; t < nt; t += 2) {
            const bool last = (t == nt - 2);
            const char* a1 = cA + (size_t)(t + 1) * kstep;
            const char* a2 = last ? nA : cA + (size_t)(t + 2) * kstep; const char* b2 = last ? nB : cB + (size_t)(t + 2) * kstep;
            const char* a3 = a2 + kstep; const char* b3 = b2 + kstep;
            PG8_LDB(B0, 0, 0); PG8_LDB(B1, 0, 1); PG8_SCHED; PG8_LDA(At, 0, 0); PG8_STAGE(PG8_SA(1, 1), a1 + hstepA, voffA);
            PG8_WAIT_V(8); PG8_WAIT_L(0); PG8_BAR; PG8_MMA(0, 0, At, B0); PG8_MMA(0, 1, At, B1); PG8_BAR; PG8_SCHED;
            PG8_LDA(At, 0, 1); PG8_STAGE(PG8_SB(0, 0), b2, voffB); PG8_STAGE(PG8_SB(0, 1), b2 + hstepB, voffB); PG8_STAGE(PG8_SA(0, 0), a2, voffA);
            PG8_WAIT_V(8); PG8_WAIT_L(0); PG8_BAR; PG8_MMA(1, 0, At, B0); PG8_MMA(1, 1, At, B1); PG8_BAR; PG8_SCHED;
            PG8_LDB(B0, 1, 0); PG8_LDB(B1, 1, 1); PG8_SCHED; PG8_LDA(At, 1, 0); PG8_STAGE(PG8_SA(0, 1), a2 + hstepA, voffA);
            PG8_WAIT_V(8); PG8_WAIT_L(0); PG8_BAR; PG8_MMA(0, 0, At, B0); PG8_MMA(0, 1, At, B1); PG8_BAR; PG8_SCHED;
            PG8_LDA(At, 1, 1); PG8_STAGE(PG8_SB(1, 0), b3, voffB); PG8_STAGE(PG8_SB(1, 1), b3 + hstepB, voffB); PG8_STAGE(PG8_SA(1, 0), a3, voffA);
            PG8_WAIT_V(8); PG8_WAIT_L(0); PG8_BAR; PG8_MMA(1, 0, At, B0); PG8_MMA(1, 1, At, B1); PG8_BAR; PG8_SCHED;
        }
        if (wr == 0) PG8_BAR;
        E(acc, cur, wr, wc, fr, fq);
        if (!has_next) break;
#pragma unroll
        for (int a = 0; a < 2; ++a)
#pragma unroll
            for (int b = 0; b < 2; ++b)
#pragma unroll
                for (int m = 0; m < 4; ++m)
#pragma unroll
                    for (int n = 0; n < 2; ++n) acc[a][b][m][n] = (f32x4){0.f, 0.f, 0.f, 0.f};
        cur = nxt; cA = nA; cB = nB; ++ui;
        if (wr == 1) PG8_BAR;
    }
    PG8_WAIT_V(0);
    PG8_BAR;
#undef PG8_SA
#undef PG8_SB
#undef PG8_STAGE
#undef PG8_LDA
#undef PG8_LDB
#undef PG8_MMA
#undef PG8_WAIT_V
#undef PG8_WAIT_L
#undef PG8_BAR
#undef PG8_SCHED
}
}
using pg8::Unit;
typedef f32x4 Acc[2][2][4][2];

__device__ __forceinline__ void store_bf16x8(bf16_t* p, f32x4 v0, f32x4 v1) {
    u32x4 w; w.x = pk2(v0[0], v0[1]); w.y = pk2(v0[2], v0[3]); w.z = pk2(v1[0], v1[1]); w.w = pk2(v1[2], v1[3]);
    *(u32x4*)p = w;
}

struct EpiG1 {
    static constexpr int MIDK = 0;
    const float* bias; unsigned char* ws; float* out;
    __device__ __forceinline__ void operator()(const Acc& acc, const Unit& u, int wr, int wc, int fr, int fq) const {
        const int pn = u.pn;
        const int rowb = u.pm * 256 + wr * 64 + fr;
        const int cl = wc * 32 + 8 * fq;
        if (pn == 20) {
            if (wc != 0 || fq == 3) return;
            float* GA = (float*)(ws + WS_GA);
            float* lfb = (u.pm < 128) ? out + O_LFP : out + O_LFS - (size_t)MP * 8;
#pragma unroll
            for (int ai = 0; ai < 2; ++ai)
#pragma unroll
                for (int m = 0; m < 4; ++m) {
                    const int row = rowb + ai * 128 + m * 16;
                    f32x4 v0 = acc[ai][0][m][0] + *(const f32x4*)(bias + pn * 256 + cl), v1 = acc[ai][0][m][1] + *(const f32x4*)(bias + pn * 256 + cl + 4);
                    if (fq < 2) { float* p = GA + (unsigned)(row * 16 + 8 * fq); *(f32x4*)p = v0; *(f32x4*)(p + 4) = v1; }
                    else {
                        float* p = lfb + (unsigned)(row * 8);
                        f32x4 a, b;
#pragma unroll
                        for (int j = 0; j < 4; ++j) { a[j] = logsigf_(v0[j]); b[j] = logsigf_(v1[j]); }
                        *(f32x4*)p = a; *(f32x4*)(p + 4) = b;
                    }
                }
            return;
        }
        bf16_t* dst; int ld, c0, act = 0; float scale = 1.f; size_t fofsP = 0, fofsS = 0; bool f32out = false;
        if (pn == 0) { dst = (bf16_t*)(ws + WS_GQ); ld = 256; c0 = 0; scale = 0.125f; }
        else if (pn == 1) { dst = (bf16_t*)(ws + WS_GK); ld = 256; c0 = 0; }
        else if (pn < 4) { dst = (bf16_t*)(ws + WS_GV); ld = 512; c0 = (pn - 2) * 256; }
        else if (pn < 6) { dst = (bf16_t*)(ws + WS_GR); ld = 512; c0 = (pn - 4) * 256; act = 1; }
        else if (pn < 8) { dst = (bf16_t*)(ws + WS_FQ); ld = 512; c0 = (pn - 6) * 256; scale = C2; }
        else if (pn < 10) { dst = (bf16_t*)(ws + WS_FK); ld = 512; c0 = (pn - 8) * 256; f32out = true; fofsP = O_FKP; fofsS = O_FKS; }
        else if (pn < 12) { dst = (bf16_t*)(ws + WS_FV); ld = 512; c0 = (pn - 10) * 256; f32out = true; fofsP = O_FVP; fofsS = O_FVS; }
        else if (pn < 16) { dst = (bf16_t*)out; ld = 1024; c0 = (pn - 12) * 256; act = 2; }
        else { dst = (bf16_t*)out + (size_t)MT * 1024; ld = 1024; c0 = (pn - 16) * 256; act = 2; }
        float* fbase = (u.pm < 128) ? out + fofsP : out + fofsS - (size_t)MP * 512;
#pragma unroll
        for (int ai = 0; ai < 2; ++ai)
#pragma unroll
            for (int m = 0; m < 4; ++m) {
                const int row = rowb + ai * 128 + m * 16;
#pragma unroll
                for (int bj = 0; bj < 2; ++bj) {
                    f32x4 v0 = acc[ai][bj][m][0] + *(const f32x4*)(bias + pn * 256 + bj * 128 + cl), v1 = acc[ai][bj][m][1] + *(const f32x4*)(bias + pn * 256 + bj * 128 + cl + 4);
                    const int col = c0 + bj * 128 + cl;
                    if (f32out) {
                        float* p = fbase + (unsigned)(row * 512 + col);
                        *(f32x4*)p = v0; *(f32x4*)(p + 4) = v1;
                    }
                    if (act == 1) {
#pragma unroll
                        for (int j = 0; j < 4; ++j) { v0[j] = siluf_(v0[j]); v1[j] = siluf_(v1[j]); }
                    } else if (act == 2) {
#pragma unroll
                        for (int j = 0; j < 4; ++j) { v0[j] = sigmoidf_(v0[j]); v1[j] = sigmoidf_(v1[j]); }
                    } else { v0 = v0 * scale; v1 = v1 * scale; }
                    store_bf16x8(dst + (unsigned)(row * ld + col), v0, v1);
                }
                asm volatile("" ::: "memory");
            }
    }
};

struct EpiM {
    static constexpr int MIDK = 0;
    const bf16_t* ZG; const bf16_t* ZF; bf16_t* MB;
    __device__ __forceinline__ void operator()(const Acc& acc, const Unit& u, int wr, int wc, int fr, int fq) const {
        const int rowb = u.pm * 256 + wr * 64 + fr, colb = u.pn * 256 + wc * 32 + 8 * fq;
        const bf16_t* Z = u.pz ? ZF : ZG;
#pragma unroll
        for (int ai = 0; ai < 2; ++ai)
#pragma unroll
            for (int m = 0; m < 4; ++m) {
                const size_t ro = (size_t)(rowb + ai * 128 + m * 16) * 1024;
#pragma unroll
                for (int bj = 0; bj < 2; ++bj) {
                    const u32x4 f = *(const u32x4*)(Z + ro + colb + bj * 128);
                    f32x4 s0 = {bflo(f.x), bfhi(f.x), bflo(f.y), bfhi(f.y)}, s1 = {bflo(f.z), bfhi(f.z), bflo(f.w), bfhi(f.w)};
                    f32x4 v0 = acc[ai][bj][m][0] * s0, v1 = acc[ai][bj][m][1] * s1;
                    if (u.pz) { const u32x4 o = *(const u32x4*)(MB + ro + colb + bj * 128);
                        v0 = v0 + (f32x4){bflo(o.x), bfhi(o.x), bflo(o.y), bfhi(o.y)}; v1 = v1 + (f32x4){bflo(o.z), bfhi(o.z), bflo(o.w), bfhi(o.w)}; }
                    store_bf16x8(MB + ro + colb + bj * 128, v0, v1);
                }
            }
    }
};

__device__ __forceinline__ void row_partial(const f32x4 (&v)[4], float& mean, float& m2) {
    float s = 0.f;
#pragma unroll
    for (int i = 0; i < 4; ++i) s += (v[i][0] + v[i][1]) + (v[i][2] + v[i][3]);
    s += __shfl_xor(s, 16); s += __shfl_xor(s, 32);
    mean = s * (1.0f / 64.0f);
    float q = 0.f;
#pragma unroll
    for (int i = 0; i < 4; ++i) { const f32x4 d = v[i] - mean; q += (d[0] * d[0] + d[1] * d[1]) + (d[2] * d[2] + d[3] * d[3]); }
    q += __shfl_xor(q, 16); q += __shfl_xor(q, 32);
    m2 = q;
}

struct EpiOut {
    static constexpr int MIDK = 0;
    const float* xp; const float* xs; bf16_t* T1; f32x2* STP;
    __device__ __forceinline__ void operator()(const Acc& acc, const Unit& u, int wr, int wc, int fr, int fq) const {
        const int rowb = u.pm * 256 + wr * 64 + fr, colb = u.pn * 256 + wc * 32 + 8 * fq;
#pragma unroll
        for (int ai = 0; ai < 2; ++ai)
#pragma unroll
            for (int m = 0; m < 4; ++m) {
                const int row = rowb + ai * 128 + m * 16;
                const float* xr = (row < MP) ? xp + (size_t)row * 1024 : xs + (size_t)(row - MP) * 1024;
                f32x4 v[4];
#pragma unroll
                for (int bj = 0; bj < 2; ++bj) {
                    const f32x4 x0 = *(const f32x4*)(xr + colb + bj * 128), x1 = *(const f32x4*)(xr + colb + bj * 128 + 4);
                    v[2 * bj] = acc[ai][bj][m][0] + x0 * DN_ALPHA; v[2 * bj + 1] = acc[ai][bj][m][1] + x1 * DN_ALPHA;
                    store_bf16x8(T1 + (size_t)row * 1024 + colb + bj * 128, v[2 * bj], v[2 * bj + 1]);
                }
                float mean, m2; row_partial(v, mean, m2);
                if (fq == 0) STP[(size_t)row * 16 + u.pn * 4 + wc] = (f32x2){mean, m2};
            }
    }
};

struct EpiSwiglu {
    static constexpr int MIDK = 0;
    const f32x2* FST; const float* GW; const float* BW; bf16_t* AH;
    __device__ __forceinline__ void operator()(const Acc& acc, const Unit& u, int wr, int wc, int fr, int fq) const {
        const int rowb = u.pm * 256 + wr * 64 + fr, cl = wc * 32 + 8 * fq;
        f32x4 gwg[2], gwu[2], bwg[2], bwu[2];
#pragma unroll
        for (int n = 0; n < 2; ++n) {
            gwg[n] = *(const f32x4*)(GW + u.pn * 256 + cl + 4 * n); gwu[n] = *(const f32x4*)(GW + u.pn * 256 + 128 + cl + 4 * n);
            bwg[n] = *(const f32x4*)(BW + u.pn * 256 + cl + 4 * n); bwu[n] = *(const f32x4*)(BW + u.pn * 256 + 128 + cl + 4 * n);
        }
#pragma unroll
        for (int ai = 0; ai < 2; ++ai)
#pragma unroll
            for (int m = 0; m < 4; ++m) {
                const int row = rowb + ai * 128 + m * 16;
                const f32x2 st = FST[row];
                f32x4 o[2];
#pragma unroll
                for (int n = 0; n < 2; ++n) {
                    const f32x4 gg = (acc[ai][0][m][n] - gwg[n] * st.x) * st.y + bwg[n];
                    const f32x4 uu = (acc[ai][1][m][n] - gwu[n] * st.x) * st.y + bwu[n];
#pragma unroll
                    for (int j = 0; j < 4; ++j) o[n][j] = siluf_(gg[j]) * uu[j];
                }
                store_bf16x8(AH + (size_t)row * DFF + u.pn * 128 + cl, o[0], o[1]);
            }
    }
};

struct EpiDown {
    static constexpr int MIDK = 0;
    const bf16_t* T1; const f32x2* FST; const float* g1; const float* b1; float* Y; f32x2* STP;
    __device__ __forceinline__ void operator()(const Acc& acc, const Unit& u, int wr, int wc, int fr, int fq) const {
        const int rowb = u.pm * 256 + wr * 64 + fr, colb = u.pn * 256 + wc * 32 + 8 * fq;
        f32x4 gv[4], bv[4];
#pragma unroll
        for (int bj = 0; bj < 2; ++bj)
#pragma unroll
            for (int n = 0; n < 2; ++n) { gv[2 * bj + n] = *(const f32x4*)(g1 + colb + bj * 128 + 4 * n); bv[2 * bj + n] = *(const f32x4*)(b1 + colb + bj * 128 + 4 * n); }
#pragma unroll
        for (int ai = 0; ai < 2; ++ai)
#pragma unroll
            for (int m = 0; m < 4; ++m) {
                const int row = rowb + ai * 128 + m * 16;
                const f32x2 st = FST[row];
                f32x4 v[4];
#pragma unroll
                for (int bj = 0; bj < 2; ++bj) {
                    const u32x4 t = *(const u32x4*)(T1 + (size_t)row * 1024 + colb + bj * 128);
                    const f32x4 t0 = {bflo(t.x), bfhi(t.x), bflo(t.y), bfhi(t.y)}, t1 = {bflo(t.z), bfhi(t.z), bflo(t.w), bfhi(t.w)};
                    const f32x4 x0 = (t0 - st.x) * st.y * gv[2 * bj] + bv[2 * bj], x1 = (t1 - st.x) * st.y * gv[2 * bj + 1] + bv[2 * bj + 1];
                    v[2 * bj] = acc[ai][bj][m][0] + x0 * DN_ALPHA; v[2 * bj + 1] = acc[ai][bj][m][1] + x1 * DN_ALPHA;
                    float* p = Y + (size_t)row * 1024 + colb + bj * 128;
                    *(f32x4*)p = v[2 * bj]; *(f32x4*)(p + 4) = v[2 * bj + 1];
                }
                float mean, m2; row_partial(v, mean, m2);
                if (fq == 0) STP[(size_t)row * 16 + u.pn * 4 + wc] = (f32x2){mean, m2};
            }
    }
};

__device__ __forceinline__ int win_src_col(int n) {
    if (n < 1024) return n;
    if (n < 3072) return n + 16;
    if (n < 5120) return n + 24;
    if (n < 5136) return 1024 + (n - 5120);
    if (n < 5144) return 3088 + (n - 5136);
    return -1;
}
__device__ __forceinline__ void transpose_item(const float* W, int ldw, int ksrc0, int scol0, bool winmap, bf16_t* WT, int ldt, int n0, int kdst0,
                                               const float* kscale, const float* bvec, float* bpart, LAS float* scr, int lane) {
    const int j = lane & 31;
    int sc = winmap ? win_src_col(n0 + j) : scol0 + j;
#pragma unroll 8
    for (int i = 0; i < 32; ++i) { const int kk = 2 * i + (lane >> 5); scr[kk * 33 + j] = (sc >= 0) ? W[(size_t)(ksrc0 + kk) * ldw + sc] : 0.f; }
    asm volatile("s_waitcnt lgkmcnt(0)" ::: "memory");
    if (bpart) {
        if (lane < 32) { float s = 0.f;
            for (int kk = 0; kk < 64; ++kk) s += bvec[ksrc0 + kk] * scr[kk * 33 + lane];
            bpart[n0 + lane] = s; }
    }
    const int c = lane & 7;
    float ks[8];
#pragma unroll
    for (int e = 0; e < 8; ++e) ks[e] = kscale ? kscale[ksrc0 + 8 * c + e] : 1.f;
#pragma unroll
    for (int jj = 0; jj < 4; ++jj) { const int n = (lane >> 3) + 8 * jj; const LAS float* s = scr + (8 * c) * 33 + n;
        u32x4 o; o.x = pk2(s[0 * 33] * ks[0], s[1 * 33] * ks[1]); o.y = pk2(s[2 * 33] * ks[2], s[3 * 33] * ks[3]); o.z = pk2(s[4 * 33] * ks[4], s[5 * 33] * ks[5]); o.w = pk2(s[6 * 33] * ks[6], s[7 * 33] * ks[7]);
        *(u32x4*)(WT + (size_t)(n0 + n) * ldt + kdst0 + 8 * c) = o; }
    asm volatile("s_waitcnt lgkmcnt(0)" ::: "memory");
}

__device__ __forceinline__ void phase0(const Params& p, LAS unsigned char* lds, int tid, int lane, int wave) {
    unsigned char* ws = PWS();
    const int G = gridDim.x, gw = blockIdx.x * 8 + wave, NGW = G * 8, gt = blockIdx.x * 512 + tid, NGT = G * 512;
    LAS float* scr = (LAS float*)(lds + wave * 16384);
    constexpr int I_WIN = 16 * (NIN / 32), I_WP = 2 * 8 * 32, I_WO = 16 * 32, I_WGU = 16 * 176, I_WD = 44 * 32;
    constexpr int NITEMS = I_WIN + I_WP + I_WO + I_WGU + I_WD;
    for (int it = gw; it < NITEMS; it += NGW) {
        int r = it;
        if (r < I_WIN) { const int kb = r / (NIN / 32), nb = r % (NIN / 32);
            transpose_item(PIN(6), 5144, 64 * kb, 0, true, (bf16_t*)(ws + WS_WIN), 1024, 32 * nb, 64 * kb, nullptr, nullptr, nullptr, scr, lane); continue; }
        r -= I_WIN;
        if (r < I_WP) { const int which = r / 256, rr = r % 256, kb = rr / 32, nb = rr % 32;
            transpose_item(which ? PIN(12) : PIN(11), 1024, 64 * kb, 32 * nb, false, (bf16_t*)(ws + WS_WP), 1024, 32 * nb, which * 512 + 64 * kb, nullptr, nullptr, nullptr, scr, lane); continue; }
        r -= I_WP;
        if (r < I_WO) { const int kb = r / 32, nb = r % 32;
            transpose_item(PIN(13), 1024, 64 * kb, 32 * nb, false, (bf16_t*)(ws + WS_WO), 1024, 32 * nb, 64 * kb, nullptr, nullptr, nullptr, scr, lane); continue; }
        r -= I_WO;
        if (r < I_WGU) { const int kb = r / 176, r32 = r % 176, pn = r32 / 8, wi = r32 % 8;
            const float* W = (wi < 4) ? PIN(16) : PIN(17); const int scol = 128 * pn + 32 * (wi & 3);
            transpose_item(W, DFF, 64 * kb, scol, false, (bf16_t*)(ws + WS_WGU), 1024, 32 * r32, 64 * kb, PIN(14), PIN(15), (float*)(ws + WS_VEC) + VO_BWP + kb * 5632, scr, lane); continue; }
        r -= I_WGU;
        { const int kb = r / 32, nb = r % 32;
            transpose_item(PIN(18), 1024, 64 * kb, 32 * nb, false, (bf16_t*)(ws + WS_WD), DFF, 32 * nb, 64 * kb, nullptr, nullptr, nullptr, scr, lane); }
    }
    for (int n = gt; n < NIN; n += NGT) { const int sc = win_src_col(n); ((float*)(ws + WS_VEC))[VO_BIAS + n] = sc >= 0 ? PIN(7)[sc] : 0.f; }
    bf16_t* XB = (bf16_t*)(ws + WS_R1);
    for (int m = gw; m < MT; m += NGW) {
        const float* xr = (m < MP) ? PIN(0) + (size_t)m * 1024 : PIN(1) + (size_t)(m - MP) * 1024;
        const f32x4* xv = (const f32x4*)xr + lane;
        u32x2* o = (u32x2*)(XB + (size_t)m * 1024) + lane;
#pragma unroll
        for (int j = 0; j < 4; ++j) { const f32x4 v = xv[64 * j]; o[64 * j] = (u32x2){pk2(v[0], v[1]), pk2(v[2], v[3])}; }
    }
    {
        float* KBLK = (float*)(ws + WS_CTL) + CW_KBLK;
        for (int idx = gt; idx < 16 * 2048 * 8; idx += NGT) {
            const int h = idx & 7, s = (idx >> 3) & 2047, b = idx >> 14;
            const f32x4* kp = (const f32x4*)(PIN(3) + ((size_t)(b * 2048 + s) * 8 + h) * 64);
            float ss = 0.f;
#pragma unroll
            for (int i = 0; i < 16; ++i) { const f32x4 v = kp[i]; ss += (v[0] * v[0] + v[1] * v[1]) + (v[2] * v[2] + v[3] * v[3]); }
            ss = fmaxf(ss, __shfl_xor(ss, 8)); ss = fmaxf(ss, __shfl_xor(ss, 16)); ss = fmaxf(ss, __shfl_xor(ss, 32));
            if (lane < 8) atomicMax((int*)(KBLK + ((2 + b) * 8 + h) * 128 + (s >> 7)), __float_as_int(ss));
        }
    }
    {
        float* CLOC = (float*)(ws + WS_CLOC); float* CTOT = (float*)(ws + WS_CTOT);
        for (int it = gw; it < 16 * 8 * 16; it += NGW) {
            const int blk = it & 15, h = (it >> 4) & 7, b = it >> 7;
            const float* lf = PIN(5) + ((size_t)b * 2048 + blk * 128) * 8 + h;
            const float v0 = lf[(2 * lane) * 8] * LOG2E, v1 = lf[(2 * lane + 1) * 8] * LOG2E;
            const float inc = wave_incl_scan(v0 + v1, lane), exc = inc - (v0 + v1);
            float* cl = CLOC + ((size_t)((2 + b) * 8 + h)) * 16384 + blk * 128;
            cl[2 * lane] = exc + v0; cl[2 * lane + 1] = inc;
            if (lane == 63) CTOT[((2 + b) * 8 + h) * 128 + blk] = inc;
        }
    }
}

constexpr int GLA_ITEMS = 2048 + 64;
__device__ __forceinline__ void gla_item_geom(int gi, int& row0, int& L, int& h, int& b) {
    if (gi < 2048) { const int bh = gi >> 8, c = gi & 255; b = bh >> 2; h = bh & 3; row0 = b * 16384 + c * 64; L = 64; }
    else { const int s = gi - 2048; b = s >> 2; h = s & 3; row0 = MP + b * 32; L = 32; }
}
constexpr int KD_STRIDE = 144, V_STRIDE = 272;
__device__ __forceinline__ void gla_pass1(int gi, const Params& p, LAS unsigned char* lds, int tid, int lane, int wave) {
    unsigned char* ws = PWS();
    int row0, L, h, b; gla_item_geom(gi, row0, L, h, b);
    LAS unsigned char* KD = lds; LAS unsigned char* VB = lds + 64 * KD_STRIDE;
    const int t = lane; const bool valid = t < L; const int row = row0 + (valid ? t : 0);
    bf16_t* GQ = (bf16_t*)(ws + WS_GQ); bf16_t* GK = (bf16_t*)(ws + WS_GK); const bf16_t* GV = (const bf16_t*)(ws + WS_GV);
    const float* GA = (const float*)(ws + WS_GA);
    f32x4 ga[4];
#pragma unroll
    for (int i = 0; i < 4; ++i) ga[i] = *(const f32x4*)(GA + (size_t)row * 16 + 4 * i);
    const int dcol = h * 64 + 8 * wave;
    float bc[8], bl[8];
#pragma unroll
    for (int i = 0; i < 8; ++i) {
        float z = PIN(9)[dcol + i];
#pragma unroll
        for (int j = 0; j < 16; ++j) z += ga[j >> 2][j & 3] * PIN(8)[j * 256 + dcol + i];
        const float la = valid ? logsigf_(z) * (1.0f / 16.0f) : 0.f;
        bc[i] = wave_incl_scan(la, lane);
        bl[i] = __shfl(bc[i], 63);
    }
    {
        const u32x4 qv = *(const u32x4*)(GQ + (size_t)row * 256 + dcol), kv = *(const u32x4*)(GK + (size_t)row * 256 + dcol);
        float q[8] = {bflo(qv.x), bfhi(qv.x), bflo(qv.y), bfhi(qv.y), bflo(qv.z), bfhi(qv.z), bflo(qv.w), bfhi(qv.w)};
        float k[8] = {bflo(kv.x), bfhi(kv.x), bflo(kv.y), bfhi(kv.y), bflo(kv.z), bfhi(kv.z), bflo(kv.w), bfhi(kv.w)};
        float qt[8], kt[8], kd[8];
#pragma unroll
        for (int i = 0; i < 8; ++i) { qt[i] = q[i] * __expf(bc[i]); kt[i] = k[i] * __expf(-bc[i]); kd[i] = valid ? k[i] * __expf(bl[i] - bc[i]) : 0.f; }
        if (valid) {
            *(u32x4*)(GQ + (size_t)row * 256 + dcol) = (u32x4){pk2(qt[0], qt[1]), pk2(qt[2], qt[3]), pk2(qt[4], qt[5]), pk2(qt[6], qt[7])};
            *(u32x4*)(GK + (size_t)row * 256 + dcol) = (u32x4){pk2(kt[0], kt[1]), pk2(kt[2], kt[3]), pk2(kt[4], kt[5]), pk2(kt[6], kt[7])};
        }
        *(LAS u32x4*)(KD + t * KD_STRIDE + 16 * wave) = (u32x4){pk2(kd[0], kd[1]), pk2(kd[2], kd[3]), pk2(kd[4], kd[5]), pk2(kd[6], kd[7])};
        if (lane == 0) { float* DEC = (float*)(ws + WS_DEC) + (size_t)gi * 64 + 8 * wave;
#pragma unroll
            for (int i = 0; i < 8; ++i) DEC[i] = __expf(bl[i]); }
    }
#pragma unroll
    for (int j = 0; j < 2; ++j) { const int ci = tid + 512 * j, r = ci >> 4, c16 = ci & 15;
        u32x4 v = {0u, 0u, 0u, 0u};
        if (r < L) v = *(const u32x4*)(GV + (size_t)(row0 + r) * 512 + h * 128 + c16 * 8);
        *(LAS u32x4*)(VB + r * V_STRIDE + c16 * 16) = v; }
    __syncthreads();
    {
        const int g = lane >> 4, i16 = lane & 15, q = i16 >> 2, pp = i16 & 3;
        f32x4 acc[4];
#pragma unroll
        for (int mt = 0; mt < 4; ++mt) acc[mt] = (f32x4){0.f, 0.f, 0.f, 0.f};
#pragma unroll
        for (int ks = 0; ks < 2; ++ks) {
            const int r0 = 32 * ks + 8 * g + q;
            const bf16x8 bfrag = tr_read2(VB + r0 * V_STRIDE + (16 * wave + 4 * pp) * 2, VB + (r0 + 4) * V_STRIDE + (16 * wave + 4 * pp) * 2);
#pragma unroll
            for (int mt = 0; mt < 4; ++mt) {
                const bf16x8 afrag = tr_read2(KD + r0 * KD_STRIDE + (16 * mt + 4 * pp) * 2, KD + (r0 + 4) * KD_STRIDE + (16 * mt + 4 * pp) * 2);
                acc[mt] = __builtin_amdgcn_mfma_f32_16x16x32_bf16(afrag, bfrag, acc[mt], 0, 0, 0);
            }
        }
        float* U = (float*)(ws + WS_R1) + (size_t)gi * 8192;
#pragma unroll
        for (int mt = 0; mt < 4; ++mt)
#pragma unroll
            for (int i = 0; i < 4; ++i) U[(16 * mt + 4 * g + i) * 128 + 16 * wave + i16] = acc[mt][i];
    }
    __syncthreads();
}

__device__ __forceinline__ void phase2(const Params& p, LAS unsigned char* lds, int tid, int lane, int wave) {
    unsigned char* ws = PWS();
    const int G = gridDim.x, gw = blockIdx.x * 8 + wave, NGW = G * 8, gt = blockIdx.x * 512 + tid, NGT = G * 512;
    for (int gi = blockIdx.x; gi < GLA_ITEMS; gi += G) gla_pass1(gi, p, lds, tid, lane, wave);
    {
        float* QMAX = (float*)(ws + WS_CTL) + CW_QMAX; float* KBLK = (float*)(ws + WS_CTL) + CW_KBLK;
        const bf16_t* FQ = (const bf16_t*)(ws + WS_FQ); const bf16_t* FK = (const bf16_t*)(ws + WS_FK);
        for (int idx = gt; idx < 2 * MT * 8; idx += NGT) {
            const int which = idx >= MT * 8, rem = which ? idx - MT * 8 : idx, h = rem & 7, m = rem >> 3;
            const u32x4* src = (const u32x4*)((which ? FK : FQ) + (size_t)m * 512 + h * 64);
            float ss = 0.f;
#pragma unroll
            for (int i = 0; i < 8; ++i) { const u32x4 v = src[i];
                const float a0 = bflo(v.x), a1 = bfhi(v.x), a2 = bflo(v.y), a3 = bfhi(v.y), a4 = bflo(v.z), a5 = bfhi(v.z), a6 = bflo(v.w), a7 = bfhi(v.w);
                ss += (a0 * a0 + a1 * a1) + (a2 * a2 + a3 * a3) + (a4 * a4 + a5 * a5) + (a6 * a6 + a7 * a7); }
            ss = fmaxf(ss, __shfl_xor(ss, 8)); ss = fmaxf(ss, __shfl_xor(ss, 16)); ss = fmaxf(ss, __shfl_xor(ss, 32));
            if (lane < 8) {
                float* dst;
                if (!which) dst = QMAX + ((m < MP) ? (m >> 7) : 256 + ((m - MP) >> 5)) * 8 + h;
                else dst = (m < MP) ? KBLK + ((m >> 14) * 8 + h) * 128 + ((m & 16383) >> 7) : KBLK + ((2 + ((m - MP) >> 5)) * 8 + h) * 128 + 16;
                atomicMax((int*)dst, __float_as_int(ss));
            }
        }
    }
    {
        float* CLOC = (float*)(ws + WS_CLOC); float* CTOT = (float*)(ws + WS_CTOT);
        for (int it = gw; it < 2048 + 128; it += NGW) {
            if (it < 2048) {
                const int blk = it & 127, h = (it >> 7) & 7, b = it >> 10;
                const float* lf = POUT() + O_LFP + ((size_t)b * 16384 + blk * 128) * 8 + h;
                const float v0 = lf[(2 * lane) * 8] * LOG2E, v1 = lf[(2 * lane + 1) * 8] * LOG2E;
                const float inc = wave_incl_scan(v0 + v1, lane), exc = inc - (v0 + v1);
                float* cl = CLOC + ((size_t)(b * 8 + h)) * 16384 + blk * 128;
                cl[2 * lane] = exc + v0; cl[2 * lane + 1] = inc;
                if (lane == 63) CTOT[(b * 8 + h) * 128 + blk] = inc;
            } else {
                const int s = it - 2048, h = s & 7, b = s >> 3;
                const float* lf = POUT() + O_LFS + ((size_t)b * 32) * 8 + h;
                const float v0 = lane < 32 ? lf[lane * 8] * LOG2E : 0.f;
                const float inc = wave_incl_scan(v0, lane);
                float* cl = CLOC + ((size_t)((2 + b) * 8 + h)) * 16384 + 2048;
                if (lane < 32) cl[lane] = inc;
                if (lane == 63) CTOT[((2 + b) * 8 + h) * 128 + 16] = inc;
            }
        }
    }
}

__device__ __forceinline__ void gla_scan(const Params& p, int lane, int wave) {
    unsigned char* ws = PWS();
    const int G = gridDim.x, gw = blockIdx.x * 8 + wave, NGW = G * 8;
    const float* U = (const float*)(ws + WS_R1); const float* DEC = (const float*)(ws + WS_DEC);
    bf16_t* SP = (bf16_t*)(ws + WS_R4);
    for (int it = gw; it < 1024; it += NGW) {
        const int bh = it >> 7, e = (it & 127) * 64 + lane, i = e >> 7;
        float s = 0.f;
        const float* up = U + (size_t)bh * 256 * 8192 + e; const float* dp = DEC + (size_t)bh * 256 * 64 + i; bf16_t* sp = SP + (size_t)bh * 256 * 8192 + e;
        for (int c0 = 0; c0 < 256; c0 += 16) {
            float uu[16], dd[16];
#pragma unroll
            for (int c = 0; c < 16; ++c) { uu[c] = up[(size_t)(c0 + c) * 8192]; dd[c] = dp[(c0 + c) * 64]; }
#pragma unroll
            for (int c = 0; c < 16; ++c) { sp[(size_t)(c0 + c) * 8192] = (bf16_t)(pk2(s, 0.f) & 0xffffu); s = dd[c] * s + uu[c]; }
        }
        POUT()[O_GSP + (size_t)bh * 8192 + e] = s;
    }
    for (int it = gw; it < 64 * 128; it += NGW) {
        const int sh = it >> 7, e = (it & 127) * 64 + lane, i = e >> 7;
        const float s0 = PIN(2)[(size_t)sh * 8192 + e];
        POUT()[O_GSS + (size_t)sh * 8192 + e] = DEC[(size_t)(2048 + sh) * 64 + i] * s0 + U[(size_t)(2048 + sh) * 8192 + e];
    }
}

constexpr int FOX_UNITS = 2048 + 128;
constexpr int AK_STRIDE = 144;
__device__ __forceinline__ void fox_unit(int ui, const Params& p, LAS unsigned char* lds, int tid, int lane, int wave) {
    unsigned char* ws = PWS();
    const bool samp = ui >= 2048;
    int b, h, I, seq, qrow0, nq, qb, krow0;
    if (!samp) { b = ui >> 10; h = (ui >> 7) & 7; I = 127 - (ui & 127); seq = b; qrow0 = b * 16384 + I * 128; nq = 128; qb = b * 128 + I; krow0 = b * 16384; }
    else { const int s = ui - 2048; b = s >> 3; h = s & 7; seq = 2 + b; I = 16; qrow0 = MP + b * 32; nq = 32; qb = 256 + b; krow0 = MP + b * 32; }
    LAS unsigned char* KL = lds; LAS unsigned char* VL = lds + 128 * AK_STRIDE; LAS float* CK = (LAS float*)(lds + 2 * 128 * AK_STRIDE);
    const bf16_t* FQ = (const bf16_t*)(ws + WS_FQ); const bf16_t* FK = (const bf16_t*)(ws + WS_FK); const bf16_t* FV = (const bf16_t*)(ws + WS_FV);
    const float* CLOC = (const float*)(ws + WS_CLOC) + (size_t)(seq * 8 + h) * 16384;
    const float* CTOT = (const float*)(ws + WS_CTOT) + (seq * 8 + h) * 128;
    const float* KBLK = (const float*)(ws + WS_CTL) + CW_KBLK + (seq * 8 + h) * 128;
    const int g = lane >> 4, i16 = lane & 15, tq = i16 >> 2, pp = i16 & 3;
    const int qi = 16 * wave + i16;
    const bool qvalid = qi < nq;
    const bool wvalid = 16 * wave < nq;
    int J0;
    {
        const float qmax = sqrtf(((const float*)(ws + WS_CTL))[CW_QMAX + qb * 8 + h]);
        float kg = 0.f;
        { float a = (lane <= I) ? KBLK[lane] : 0.f; float c = (lane + 64 <= I) ? KBLK[lane + 64] : 0.f; a = fmaxf(a, c);
#pragma unroll
          for (int o = 1; o < 64; o <<= 1) a = fmaxf(a, __shfl_xor(a, o));
          kg = sqrtf(a); }
        const float base = qmax * kg + qmax * sqrtf(KBLK[I]);
        int J = I - 1; float Dsum = 0.f;
        while (J >= 0 && !(base + Dsum < -THR2)) { Dsum += CTOT[J]; --J; }
        J0 = J + 1;
    }
    bf16x8 qf[2];
    float cq2 = 0.f;
    {
        const bf16_t* qp = FQ + (size_t)(qrow0 + (qvalid ? qi : 0)) * 512 + h * 64 + 8 * g;
        qf[0] = *(const bf16x8*)qp; qf[1] = *(const bf16x8*)(qp + 32);
        cq2 = CLOC[(samp ? 2048 : I * 128) + (qvalid ? qi : 0)];
    }
    float mrun = -1e30f, lpart = 0.f;
    f32x4 o[4];
#pragma unroll
    for (int dt = 0; dt < 4; ++dt) o[dt] = (f32x4){0.f, 0.f, 0.f, 0.f};
    float dlt = 0.f;
    for (int J = I; J >= J0; --J) {
        if (J < I) dlt += CTOT[J];
        __syncthreads();
#pragma unroll
        for (int j = 0; j < 2; ++j) {
            const int ci = tid + 512 * j, r = ci >> 3, c16 = ci & 7;
            u32x4 kv = {0u, 0u, 0u, 0u}, vv = {0u, 0u, 0u, 0u};
            if (!samp) {
                const size_t go = (size_t)(krow0 + J * 128 + r) * 512 + h * 64 + c16 * 8;
                kv = *(const u32x4*)(FK + go); vv = *(const u32x4*)(FV + go);
            } else if (J == 16) {
                if (r < 32) { const size_t go = (size_t)(krow0 + r) * 512 + h * 64 + c16 * 8; kv = *(const u32x4*)(FK + go); vv = *(const u32x4*)(FV + go); }
            } else {
                const size_t go = ((size_t)(b * 2048 + J * 128 + r) * 8 + h) * 64 + c16 * 8;
                const f32x4 k0 = *(const f32x4*)(PIN(3) + go), k1 = *(const f32x4*)(PIN(3) + go + 4), v0 = *(const f32x4*)(PIN(4) + go), v1 = *(const f32x4*)(PIN(4) + go + 4);
                kv = (u32x4){pk2(k0[0], k0[1]), pk2(k0[2], k0[3]), pk2(k1[0], k1[1]), pk2(k1[2], k1[3])};
                vv = (u32x4){pk2(v0[0], v0[1]), pk2(v0[2], v0[3]), pk2(v1[0], v1[1]), pk2(v1[2], v1[3])};
            }
            *(LAS u32x4*)(KL + r * AK_STRIDE + c16 * 16) = kv; *(LAS u32x4*)(VL + r * AK_STRIDE + c16 * 16) = vv;
        }
        if (tid < 128) CK[tid] = (samp && J == 16 && tid >= 32) ? 0.f : CLOC[J * 128 + tid];
        __syncthreads();
        if (!wvalid) continue;
        f32x4 s[8];
        const float cqe = cq2 + dlt;
#pragma unroll
        for (int kt = 0; kt < 8; ++kt) {
            const f32x4 ck = *(const LAS f32x4*)(CK + 16 * kt + 4 * g);
            f32x4 c = {cqe - ck[0], cqe - ck[1], cqe - ck[2], cqe - ck[3]};
            const bf16x8 k0 = *(const LAS bf16x8*)(KL + (16 * kt + i16) * AK_STRIDE + 16 * g);
            const bf16x8 k1 = *(const LAS bf16x8*)(KL + (16 * kt + i16) * AK_STRIDE + 64 + 16 * g);
            c = __builtin_amdgcn_mfma_f32_16x16x32_bf16(k0, qf[0], c, 0, 0, 0);
            c = __builtin_amdgcn_mfma_f32_16x16x32_bf16(k1, qf[1], c, 0, 0, 0);
            s[kt] = c;
        }
        if (J == I) {
#pragma unroll
            for (int kt = 0; kt < 8; ++kt)
#pragma unroll
                for (int i = 0; i < 4; ++i) if (16 * kt + 4 * g + i > qi) s[kt][i] = -1e30f;
        }
        float mt = -1e30f;
#pragma unroll
        for (int kt = 0; kt < 8; ++kt) mt = fmaxf(mt, fmaxf(fmaxf(s[kt][0], s[kt][1]), fmaxf(s[kt][2], s[kt][3])));
        mt = fmaxf(mt, __shfl_xor(mt, 16)); mt = fmaxf(mt, __shfl_xor(mt, 32));
        const float mnew = fmaxf(mrun, mt);
        const float alpha = exp2f(mrun - mnew);
        mrun = mnew;
        float ps = 0.f;
#pragma unroll
        for (int kt = 0; kt < 8; ++kt)
#pragma unroll
            for (int i = 0; i < 4; ++i) { const float e = exp2f(s[kt][i] - mnew); s[kt][i] = e; ps += e; }
        lpart = lpart * alpha + ps;
#pragma unroll
        for (int dt = 0; dt < 4; ++dt) o[dt] = o[dt] * alpha;
#pragma unroll
        for (int kk = 0; kk < 4; ++kk) {
            const bf16x8 pf = pack8(s[2 * kk], s[2 * kk + 1]);
            const int r0 = 32 * kk + 4 * g + tq;
#pragma unroll
            for (int dt = 0; dt < 4; ++dt) {
                const bf16x8 vf = tr_read2(VL + r0 * AK_STRIDE + (16 * dt + 4 * pp) * 2, VL + (r0 + 16) * AK_STRIDE + (16 * dt + 4 * pp) * 2);
                o[dt] = __builtin_amdgcn_mfma_f32_16x16x32_bf16(vf, pf, o[dt], 0, 0, 0);
            }
        }
    }
    if (wvalid) {
        float l = lpart; l += __shfl_xor(l, 16); l += __shfl_xor(l, 32);
        const float inv = 1.0f / l;
        if (qvalid) {
            bf16_t* op = (bf16_t*)(ws + WS_OGF) + (size_t)(qrow0 + qi) * 1024 + 512 + h * 64 + 4 * g;
#pragma unroll
            for (int dt = 0; dt < 4; ++dt) *(u32x2*)(op + 16 * dt) = (u32x2){pk2(o[dt][0] * inv, o[dt][1] * inv), pk2(o[dt][2] * inv, o[dt][3] * inv)};
        }
    }
}

__device__ __forceinline__ void phase3(const Params& p, LAS unsigned char* lds, int tid, int lane, int wave) {
    gla_scan(p, lane, wave);
    unsigned* ctr = (unsigned*)(PWS() + WS_CTL) + CW_ACTR;
    LAS int* slot = (LAS int*)(lds + 131072);
    for (;;) {
        __syncthreads();
        if (tid == 0) slot[0] = (int)atomicAdd(ctr, 1u);
        __syncthreads();
        const int ui = slot[0];
        if (ui >= FOX_UNITS) break;
        fox_unit(ui, p, lds, tid, lane, wave);
    }
}

__device__ __forceinline__ void gla_pass3(int gi, const Params& p, LAS unsigned char* lds, int tid, int lane, int wave) {
    unsigned char* ws = PWS();
    int row0, L, h, b; gla_item_geom(gi, row0, L, h, b);
    LAS unsigned char* QT = lds; LAS unsigned char* KT = lds + 64 * KD_STRIDE; LAS unsigned char* VB = lds + 2 * 64 * KD_STRIDE; LAS unsigned char* SB = VB + 64 * V_STRIDE;
    LAS float* SSQ = (LAS float*)(SB + 64 * V_STRIDE);
    const bf16_t* GQ = (const bf16_t*)(ws + WS_GQ); const bf16_t* GK = (const bf16_t*)(ws + WS_GK); const bf16_t* GV = (const bf16_t*)(ws + WS_GV);
    __syncthreads();
    { const int r = tid >> 3, c16 = tid & 7;
        u32x4 qv = {0u, 0u, 0u, 0u}, kv = {0u, 0u, 0u, 0u};
        if (r < L) { qv = *(const u32x4*)(GQ + (size_t)(row0 + r) * 256 + h * 64 + c16 * 8); kv = *(const u32x4*)(GK + (size_t)(row0 + r) * 256 + h * 64 + c16 * 8); }
        *(LAS u32x4*)(QT + r * KD_STRIDE + c16 * 16) = qv; *(LAS u32x4*)(KT + r * KD_STRIDE + c16 * 16) = kv; }
#pragma unroll
    for (int j = 0; j < 2; ++j) { const int ci = tid + 512 * j, r = ci >> 4, c16 = ci & 15;
        u32x4 v = {0u, 0u, 0u, 0u}, sv;
        if (r < L) v = *(const u32x4*)(GV + (size_t)(row0 + r) * 512 + h * 128 + c16 * 8);
        *(LAS u32x4*)(VB + r * V_STRIDE + c16 * 16) = v;
        if (gi < 2048) sv = *(const u32x4*)((const bf16_t*)(ws + WS_R4) + (size_t)gi * 8192 + r * 128 + c16 * 8);
        else { const float* sp = PIN(2) + (size_t)(gi - 2048) * 8192 + r * 128 + c16 * 8; const f32x4 a = *(const f32x4*)sp, c = *(const f32x4*)(sp + 4);
            sv = (u32x4){pk2(a[0], a[1]), pk2(a[2], a[3]), pk2(c[0], c[1]), pk2(c[2], c[3])}; }
        *(LAS u32x4*)(SB + r * V_STRIDE + c16 * 16) = sv; }
    __syncthreads();
    const int g = lane >> 4, i16 = lane & 15, tq = i16 >> 2, pp = i16 & 3;
    const int tt = wave & 3, dh = wave >> 2;
    bf16x8 qf[2];
    qf[0] = *(const LAS bf16x8*)(QT + (16 * tt + i16) * KD_STRIDE + 16 * g); qf[1] = *(const LAS bf16x8*)(QT + (16 * tt + i16) * KD_STRIDE + 64 + 16 * g);
    f32x4 at[4];
#pragma unroll
    for (int st = 0; st < 4; ++st) {
        f32x4 c = {0.f, 0.f, 0.f, 0.f};
        if (st <= tt) {
            const bf16x8 k0 = *(const LAS bf16x8*)(KT + (16 * st + i16) * KD_STRIDE + 16 * g), k1 = *(const LAS bf16x8*)(KT + (16 * st + i16) * KD_STRIDE + 64 + 16 * g);
            c = __builtin_amdgcn_mfma_f32_16x16x32_bf16(k0, qf[0], c, 0, 0, 0);
            c = __builtin_amdgcn_mfma_f32_16x16x32_bf16(k1, qf[1], c, 0, 0, 0);
            if (st == tt) {
#pragma unroll
                for (int i = 0; i < 4; ++i) if (4 * g + i > i16) c[i] = 0.f;
            }
        }
        at[st] = c;
    }
    bf16x8 pf[2]; pf[0] = pack8(at[0], at[1]); pf[1] = pack8(at[2], at[3]);
    f32x4 o[4]; float ssq = 0.f;
#pragma unroll
    for (int dl = 0; dl < 4; ++dl) {
        const int dt = 4 * dh + dl;
        f32x4 c = {0.f, 0.f, 0.f, 0.f};
#pragma unroll
        for (int ks = 0; ks < 2; ++ks) {
            const int r0 = 32 * ks + 4 * g + tq;
            const bf16x8 vf = tr_read2(VB + r0 * V_STRIDE + (16 * dt + 4 * pp) * 2, VB + (r0 + 16) * V_STRIDE + (16 * dt + 4 * pp) * 2);
            c = __builtin_amdgcn_mfma_f32_16x16x32_bf16(vf, pf[ks], c, 0, 0, 0);
            const int r1 = 32 * ks + 8 * g + tq;
            const bf16x8 sf = tr_read2(SB + r1 * V_STRIDE + (16 * dt + 4 * pp) * 2, SB + (r1 + 4) * V_STRIDE + (16 * dt + 4 * pp) * 2);
            c = __builtin_amdgcn_mfma_f32_16x16x32_bf16(sf, qf[ks], c, 0, 0, 0);
        }
        o[dl] = c; ssq += (c[0] * c[0] + c[1] * c[1]) + (c[2] * c[2] + c[3] * c[3]);
    }
    ssq += __shfl_xor(ssq, 16); ssq += __shfl_xor(ssq, 32);
    if (g == 0) SSQ[dh * 64 + 16 * tt + i16] = ssq;
    __syncthreads();
    const int t = 16 * tt + i16;
    const float rstd = rsqrtf((SSQ[t] + SSQ[64 + t]) * (1.0f / 128.0f) + 1e-5f);
    if (t < L) {
        const bf16_t* GR = (const bf16_t*)(ws + WS_GR) + (size_t)(row0 + t) * 512 + h * 128;
        bf16_t* OG = (bf16_t*)(ws + WS_OGF) + (size_t)(row0 + t) * 1024 + h * 128;
#pragma unroll
        for (int dl = 0; dl < 4; ++dl) {
            const int dv = 16 * (4 * dh + dl) + 4 * g;
            const u32x2 gr = *(const u32x2*)(GR + dv);
            const f32x4 gn = *(const f32x4*)(PIN(10) + h * 128 + dv);
            const float v0 = o[dl][0] * rstd * gn[0] * bflo(gr.x), v1 = o[dl][1] * rstd * gn[1] * bfhi(gr.x), v2 = o[dl][2] * rstd * gn[2] * bflo(gr.y), v3 = o[dl][3] * rstd * gn[3] * bfhi(gr.y);
            *(u32x2*)(OG + dv) = (u32x2){pk2(v0, v1), pk2(v2, v3)};
        }
    }
}

__device__ __forceinline__ void phase_stats1(const Params& p, int tid, int lane, int wave) {
    unsigned char* ws = PWS();
    const int G = gridDim.x, gw = blockIdx.x * 8 + wave, NGW = G * 8, gt = blockIdx.x * 512 + tid, NGT = G * 512;
    const f32x2* STP = (const f32x2*)(ws + WS_STP1); f32x2* FST = (f32x2*)(ws + WS_FST1);
    for (int r = gt; r < MT; r += NGT) {
        f32x2 pt[16]; float ms = 0.f;
#pragma unroll
        for (int i = 0; i < 16; ++i) { pt[i] = STP[(size_t)r * 16 + i]; ms += pt[i].x; }
        const float mean = ms * (1.0f / 16.0f); float q = 0.f;
#pragma unroll
        for (int i = 0; i < 16; ++i) { const float d = pt[i].x - mean; q += pt[i].y + 64.0f * d * d; }
        FST[r] = (f32x2){mean, rsqrtf(q * (1.0f / 1024.0f) + 1e-5f)};
    }
    float* vec = (float*)(ws + WS_VEC);
    const bf16_t* WGU = (const bf16_t*)(ws + WS_WGU);
    for (int c = gw; c < 5632; c += NGW) {
        const u32x4* rp = (const u32x4*)(WGU + (size_t)c * 1024) + lane * 2;
        float s = 0.f;
#pragma unroll
        for (int i = 0; i < 2; ++i) { const u32x4 v = rp[i]; s += (bflo(v.x) + bfhi(v.x)) + (bflo(v.y) + bfhi(v.y)) + (bflo(v.z) + bfhi(v.z)) + (bflo(v.w) + bfhi(v.w)); }
#pragma unroll
        for (int o = 1; o < 64; o <<= 1) s += __shfl_xor(s, o);
        if (lane == 0) vec[VO_GW + c] = s;
    }
    for (int c = gt; c < 5632; c += NGT) { float s = 0.f;
#pragma unroll
        for (int kb = 0; kb < 16; ++kb) s += vec[VO_BWP + kb * 5632 + c];
        vec[VO_BW + c] = s; }
}

__device__ __forceinline__ void phase_final_ln(const Params& p, int lane, int wave) {
    unsigned char* ws = PWS();
    const int G = gridDim.x, gw = blockIdx.x * 8 + wave, NGW = G * 8;
    const f32x2* STP = (const f32x2*)(ws + WS_STP2);
    for (int r = gw; r < MT; r += NGW) {
        const f32x2 pt = STP[(size_t)r * 16 + (lane & 15)];
        float ms = pt.x;
        ms += __shfl_xor(ms, 1); ms += __shfl_xor(ms, 2); ms += __shfl_xor(ms, 4); ms += __shfl_xor(ms, 8);
        const float mean = ms * (1.0f / 16.0f);
        const float d = pt.x - mean; float q = pt.y + 64.0f * d * d;
        q += __shfl_xor(q, 1); q += __shfl_xor(q, 2); q += __shfl_xor(q, 4); q += __shfl_xor(q, 8);
        const float rstd = rsqrtf(q * (1.0f / 1024.0f) + 1e-5f);
        f32x4* y = (f32x4*)(POUT() + (size_t)r * 1024) + lane;
        const f32x4* gg = (const f32x4*)PIN(19) + lane; const f32x4* bb = (const f32x4*)PIN(20) + lane;
#pragma unroll
        for (int j = 0; j < 4; ++j) { const f32x4 v = y[64 * j]; y[64 * j] = (v - mean) * rstd * gg[64 * j] + bb[64 * j]; }
    }
}

__global__ void __launch_bounds__(512, 2) fwd_megakernel(Params p) {
    extern __shared__ __attribute__((aligned(16))) unsigned char lds_raw[];
    LAS unsigned char* lds = (LAS unsigned char*)lds_raw;
    cg::grid_group grid = cg::this_grid();
#define TLW int tid_ = threadIdx.x; asm volatile("" : "+v"(tid_)); const int tid = tid_, lane = tid & 63, wave = __builtin_amdgcn_readfirstlane(tid >> 6); (void)lane; (void)wave

#ifndef SKIP_P0
    { TLW; phase0(p, lds, tid, lane, wave); }
#endif
    grid.sync();
#ifndef SKIP_P1
    {
        unsigned char* ws = PWS(); const int G = gridDim.x;
        pg8::Gemm g{(const bf16_t*)(ws + WS_R1), (const bf16_t*)(ws + WS_WIN), MT, NIN, 1024, 1024, 1024, nullptr, nullptr}; pg8::StaticOrder S; S.init(MT, NIN, G, (int)blockIdx.x);
        EpiG1 E{(const float*)(ws + WS_VEC) + VO_BIAS, ws, POUT()};
        pg8::gemm_phase<EpiG1>(lds, g, S, E);
    }
#endif
    grid.sync();
#ifndef SKIP_P2
    { TLW; phase2(p, lds, tid, lane, wave); }
#endif
    grid.sync();
#ifndef SKIP_P3
    { TLW; phase3(p, lds, tid, lane, wave); }
#endif
    grid.sync();
#ifndef SKIP_P4
    { TLW; for (int gi = blockIdx.x; gi < GLA_ITEMS; gi += (int)gridDim.x) gla_pass3(gi, p, lds, tid, lane, wave); }
#endif
    grid.sync();
#ifndef SKIP_P5
    {
        unsigned char* ws = PWS(); const int G = gridDim.x;
        pg8::Gemm g{(const bf16_t*)(ws + WS_OGF), (const bf16_t*)(ws + WS_WP), MT, 1024, 512, 1024, 1024, (const bf16_t*)(ws + WS_OGF) + 512, (const bf16_t*)(ws + WS_WP) + 512}; pg8::StaticOrder S; S.init(MT, 1024, G, (int)blockIdx.x, 1);
        EpiM E{(const bf16_t*)POUT(), (const bf16_t*)POUT() + (size_t)MT * 1024, (bf16_t*)(ws + WS_R1)};
        pg8::gemm_phase<EpiM>(lds, g, S, E);
    }
#endif
    grid.sync();
#ifndef SKIP_P6
    {
        unsigned char* ws = PWS(); const int G = gridDim.x;
        pg8::Gemm g{(const bf16_t*)(ws + WS_R1), (const bf16_t*)(ws + WS_WO), MT, 1024, 1024, 1024, 1024, nullptr, nullptr}; pg8::StaticOrder S; S.init(MT, 1024, G, (int)blockIdx.x);
        EpiOut E{PIN(0), PIN(1), (bf16_t*)(ws + WS_R2), (f32x2*)(ws + WS_STP1)};
        pg8::gemm_phase<EpiOut>(lds, g, S, E);
    }
#endif
    grid.sync();
#ifndef SKIP_P6B
    { TLW; phase_stats1(p, tid, lane, wave); }
#endif
    grid.sync();
#ifndef SKIP_P7
    {
        unsigned char* ws = PWS(); const int G = gridDim.x;
        pg8::Gemm g{(const bf16_t*)(ws + WS_R2), (const bf16_t*)(ws + WS_WGU), MT, 5632, 1024, 1024, 1024, nullptr, nullptr}; pg8::StaticOrder S; S.init(MT, 5632, G, (int)blockIdx.x);
        EpiSwiglu E{(const f32x2*)(ws + WS_FST1), (const float*)(ws + WS_VEC) + VO_GW, (const float*)(ws + WS_VEC) + VO_BW, (bf16_t*)(ws + WS_R3)};
        pg8::gemm_phase<EpiSwiglu>(lds, g, S, E);
    }
#endif
    grid.sync();
#ifndef SKIP_P8
    {
        unsigned char* ws = PWS(); const int G = gridDim.x;
        pg8::Gemm g{(const bf16_t*)(ws + WS_R3), (const bf16_t*)(ws + WS_WD), MT, 1024, DFF, DFF, DFF, nullptr, nullptr}; pg8::StaticOrder S; S.init(MT, 1024, G, (int)blockIdx.x);
        EpiDown E{(const bf16_t*)(ws + WS_R2), (const f32x2*)(ws + WS_FST1), PIN(14), PIN(15), POUT(), (f32x2*)(ws + WS_STP2)};
        pg8::gemm_phase<EpiDown>(lds, g, S, E);
    }
#endif
    grid.sync();
#ifndef SKIP_P9
    { TLW; phase_final_ln(p, lane, wave); }
#endif
}

extern "C" void kernel_launch(void* const* d_in, const int* in_sizes, int n_in, void* d_out, int out_size, void* d_ws, size_t ws_size, hipStream_t stream) {
    static int grid_blocks = 0;
    if (grid_blocks == 0) {
        if (n_in != 21 || ws_size < WS_END) { fprintf(stderr, "kernel_launch: unexpected n_in %d / ws_size %zu\n", n_in, ws_size); grid_blocks = -1; return; }
        int dev = 0, cus = 0, per_cu = 0;
        hipGetDevice(&dev);
        hipDeviceGetAttribute(&cus, hipDeviceAttributeMultiprocessorCount, dev);
        hipFuncSetAttribute((const void*)fwd_megakernel, hipFuncAttributeMaxDynamicSharedMemorySize, LDS_BYTES);
        hipOccupancyMaxActiveBlocksPerMultiprocessor(&per_cu, (const void*)fwd_megakernel, 512, LDS_BYTES);
        if (per_cu < 1) { fprintf(stderr, "kernel_launch: occupancy query returned %d\n", per_cu); per_cu = 1; }
        grid_blocks = cus * 1;
        (void)hipGetLastError();
    }
    if (grid_blocks < 0) return;
    hipMemsetAsync((char*)d_ws + WS_CTL, 0, CTL_BYTES, stream);
    Params p{};
    for (int i = 0; i < 21; ++i) p.in[i] = (const float*)d_in[i];
    p.out = (float*)d_out; p.ws = (unsigned char*)d_ws;
    void* args[] = {&p};
    hipError_t e = hipLaunchCooperativeKernel((const void*)fwd_megakernel, dim3(grid_blocks), dim3(512), args, LDS_BYTES, stream);
    if (e != hipSuccess) fprintf(stderr, "cooperative launch failed: %s (grid %d)\n", hipGetErrorString(e), grid_blocks);
}
```

```cpp
#include <hip/hip_runtime.h>
#include <hip/hip_cooperative_groups.h>
#include <cstdio>
#include <cstdint>
namespace cg = cooperative_groups;

#define LAS __attribute__((address_space(3)))
typedef unsigned short bf16_t;
typedef short bf16x8 __attribute__((ext_vector_type(8)));
typedef short s16x4 __attribute__((ext_vector_type(4)));
typedef float f32x4 __attribute__((ext_vector_type(4)));
typedef float f32x2 __attribute__((ext_vector_type(2)));
typedef unsigned u32x4 __attribute__((ext_vector_type(4)));
typedef unsigned u32x2 __attribute__((ext_vector_type(2)));
typedef __bf16 bf16x2_t __attribute__((ext_vector_type(2)));

#ifndef DUP_P0
#define DUP_P0 1
#endif
#ifndef DUP_P2
#define DUP_P2 1
#endif
#ifndef DUP_P3
#define DUP_P3 1
#endif
#ifndef DUP_P4
#define DUP_P4 1
#endif
#ifndef DUP_ALL_GEMM
#define DUP_ALL_GEMM 1
#endif
#define DUP_EPIG1 DUP_ALL_GEMM
#define DUP_EPIM DUP_ALL_GEMM
#define DUP_EPIOUT DUP_ALL_GEMM
#define DUP_EPISWIGLU DUP_ALL_GEMM
#define DUP_EPIDOWN DUP_ALL_GEMM
constexpr int MP = 32768, MS = 512, MT = 33280, DM = 1024, DFF = 2816;
constexpr int NIN = 5376;
constexpr float DN_ALPHA = 1.189207115002721f;
constexpr float LOG2E = 1.4426950408889634f;
constexpr float C2 = 0.125f * LOG2E;
constexpr float THR2 = 60.0f;
constexpr size_t O_Y = 0;
constexpr size_t O_GSP = (size_t)MT * 1024;
constexpr size_t O_FKP = O_GSP + 65536;
constexpr size_t O_FVP = O_FKP + (size_t)MP * 512;
constexpr size_t O_LFP = O_FVP + (size_t)MP * 512;
constexpr size_t O_GSS = O_LFP + (size_t)MP * 8;
constexpr size_t O_FKS = O_GSS + 524288;
constexpr size_t O_FVS = O_FKS + 262144;
constexpr size_t O_LFS = O_FVS + 262144;
constexpr size_t MiB = 1u << 20;
constexpr size_t WS_CTL = 0, CTL_BYTES = 1 * MiB;
constexpr size_t WS_VEC = 1 * MiB;
constexpr size_t WS_WIN = 2 * MiB, WS_WP = 13 * MiB, WS_WO = 15 * MiB, WS_WGU = 17 * MiB, WS_WD = 28 * MiB;
constexpr size_t WS_GA = 34 * MiB, WS_STP1 = 37 * MiB, WS_STP2 = 42 * MiB, WS_FST1 = 47 * MiB;
constexpr size_t WS_CLOC = 48 * MiB, WS_CTOT = 57 * MiB, WS_DEC = 58 * MiB;
constexpr size_t WS_R1 = 60 * MiB;
constexpr size_t WS_R2 = 127 * MiB;
constexpr size_t WS_GQ = WS_R2, WS_GK = WS_GQ + (size_t)MT * 256 * 2, WS_GV = WS_GK + (size_t)MT * 256 * 2;
constexpr size_t WS_R3 = 192 * MiB;
constexpr size_t WS_GR = WS_R3, WS_FQ = WS_GR + (size_t)MT * 512 * 2, WS_FK = WS_FQ + (size_t)MT * 512 * 2, WS_FV = WS_FK + (size_t)MT * 512 * 2, WS_OGF = WS_FV + (size_t)MT * 512 * 2;
constexpr size_t WS_R4 = 387 * MiB;
constexpr size_t WS_GQT = 420 * MiB, WS_GKT = WS_GQT + (size_t)MT * 256 * 2;
constexpr size_t WS_END = 456 * MiB;
constexpr int CW_ACTR = 0;
constexpr int CW_QMAX = 64;
constexpr int CW_KBLK = 4096;
constexpr int CW_BAR = 65536;
constexpr int VO_BIAS = 0, VO_GW = 5376, VO_BW = 5376 + 5632, VO_BWP = 5376 + 2 * 5632;

constexpr int LDS_BYTES = 131072 + 1024;

__device__ __forceinline__ unsigned pk2(float lo, float hi) { f32x2 v = {lo, hi}; bf16x2_t b = __builtin_convertvector(v, bf16x2_t); return __builtin_bit_cast(unsigned, b); }
__device__ __forceinline__ float bflo(unsigned w) { return __uint_as_float(w << 16); }
__device__ __forceinline__ float bfhi(unsigned w) { return __uint_as_float(w & 0xffff0000u); }
__device__ __forceinline__ float sigmoidf_(float x) { return __builtin_amdgcn_rcpf(1.0f + __expf(-x)); }
__device__ __forceinline__ float siluf_(float x) { return x * __builtin_amdgcn_rcpf(1.0f + __expf(-x)); }
__device__ __forceinline__ float logsigf_(float z) { return fminf(z, 0.f) - __logf(1.0f + __expf(-fabsf(z))); }
__device__ __forceinline__ float wave_incl_scan(float v, int lane) {
#pragma unroll
    for (int o = 1; o < 64; o <<= 1) { float t = __shfl_up(v, o); if (lane >= o) v += t; }
    return v;
}
__device__ __forceinline__ bf16x8 tr_read2(const LAS unsigned char* p0, const LAS unsigned char* p1) {
    s16x4 a = __builtin_bit_cast(s16x4, __builtin_amdgcn_ds_read_tr16_b64_v4i16((LAS s16x4*)p0));
    s16x4 b = __builtin_bit_cast(s16x4, __builtin_amdgcn_ds_read_tr16_b64_v4i16((LAS s16x4*)p1));
    return (bf16x8){a[0], a[1], a[2], a[3], b[0], b[1], b[2], b[3]};
}
__device__ __forceinline__ bf16x8 pack8(f32x4 a, f32x4 b) {
    u32x4 w; w.x = pk2(a[0], a[1]); w.y = pk2(a[2], a[3]); w.z = pk2(b[0], b[1]); w.w = pk2(b[2], b[3]);
    return __builtin_bit_cast(bf16x8, w);
}

struct Params {
    const float* in[21];
    float* out;
    unsigned char* ws;
};


typedef __attribute__((address_space(4))) const unsigned char* kptr_t;
__device__ __forceinline__ kptr_t kargs_() { kptr_t k = (kptr_t)__builtin_amdgcn_kernarg_segment_ptr(); asm volatile("" : "+s"(k)); return k; }
typedef const float* cfptr_t; typedef float* fptr_t; typedef unsigned char* ucptr_t;
#define PIN(i) (*(const __attribute__((address_space(4))) cfptr_t*)(kargs_() + 8 * (i)))
#define POUT() (*(const __attribute__((address_space(4))) fptr_t*)(kargs_() + 8 * 21))
#define PWS() (*(const __attribute__((address_space(4))) ucptr_t*)(kargs_() + 8 * 22))

namespace pg8 {
constexpr int BM = 256, BK = 64, HALF = 128, HTB = HALF * BK * 2, STAGE_BYTES = 8 * HTB, NXCD = 8, WGM = 8;
__host__ __device__ __forceinline__ int lds_byte(int r, int c) { const int st = (r >> 4) * 2 + (c >> 5), rr = r & 15, cc = c & 31, ob = rr * 64 + cc * 2; return st * 1024 + (ob ^ (((ob >> 9) & 1) << 5)); }
__host__ __device__ __forceinline__ void stage_rc(int b, int& R, int& C) { const int st = b / 1024, sb = b % 1024, swz = sb ^ (((sb >> 9) & 1) << 5); R = (st >> 1) * 16 + swz / 64; C = (st & 1) * 32 + (swz % 64) / 2; }
__host__ __device__ __forceinline__ int perm32(int rho) { const int n = rho >> 4, i = rho & 15; return 8 * (i >> 2) + 4 * n + (i & 3); }
struct Unit { int pm, pn, pz; };
struct Gemm { const bf16_t* A; const bf16_t* Bt; int M, N, K, lda, ldb; const bf16_t* A2; const bf16_t* Bt2; };
struct StaticOrder {
    int nM, nN, nwg, G, c, zs;
    __host__ __device__ void init(int M, int N, int G_, int c_, int zs_ = 0) { nM = M / BM; nN = N / BM; nwg = nM * nN; G = G_; c = c_; zs = zs_; }
    __host__ __device__ bool next(int i, Unit& u) const {
        u.pz = zs ? (i & 1) : 0; if (zs) i >>= 1;
        const long L = (long)i * G + c; if (L >= nwg) return false;
        int wgid = (int)L; { const int q = nwg / NXCD, r = nwg % NXCD, xcd = wgid % NXCD, off = wgid / NXCD; wgid = (xcd < r ? xcd * (q + 1) : r * (q + 1) + (xcd - r) * q) + off; }
        const int nig = WGM * nN, gid = wgid / nig, fm = gid * WGM, gsz = (nM - fm) < WGM ? (nM - fm) : WGM;
        u.pm = fm + ((wgid % nig) % gsz); u.pn = (wgid % nig) / gsz; return true;
    }
};
template <class Epi>
__device__ __forceinline__ void gemm_phase(LAS unsigned char* lds, const Gemm g, const StaticOrder& S, const Epi& E) {
    int tid = threadIdx.x; asm volatile("" : "+v"(tid));
    const int wid = __builtin_amdgcn_readfirstlane(tid >> 6), lane = tid & 63, wr = wid >> 2, wc = wid & 3, fr = lane & 15, fq = lane >> 4;
    const int K = g.K, nt = K / BK;
    unsigned voffA[2], voffB[2];
#pragma unroll
    for (int i = 0; i < 2; ++i) { int R, C; stage_rc(tid * 16 + i * 8192, R, C); const int Rb = (R & ~31) + perm32(R & 31);
        voffA[i] = (unsigned)(R * g.lda + C) * 2u; voffB[i] = (unsigned)(Rb * g.ldb + C) * 2u; }
    const size_t kstep = (size_t)(BK * 2);
    const size_t hstepA = (size_t)HALF * g.lda * 2, hstepB = (size_t)HALF * g.ldb * 2;
    const size_t tstepA = 2 * hstepA, tstepB = 2 * hstepB;
    const unsigned ldsw = (unsigned)wid * 1024u;
    const int aoff = lds_byte(wr * 64 + fr, fq * 8), boff = lds_byte(wc * 32 + fr, fq * 8);
#define PG8_SA(b, h) (((b) * 2 + (h)) * HTB)
#define PG8_SB(b, h) ((4 + (b) * 2 + (h)) * HTB)
#define PG8_STAGE(bufoff, gbase, voff) do { _Pragma("unroll") for (int _i = 0; _i < 2; ++_i) \
        __builtin_amdgcn_global_load_lds((const unsigned*)((const char*)(gbase) + (voff)[_i]), (LAS unsigned*)(lds + (bufoff) + ldsw + _i * 8192), 16, 0, 0); } while (0)
#define PG8_LDA(dst, b, h) do { _Pragma("unroll") for (int m = 0; m < 4; ++m) _Pragma("unroll") for (int k = 0; k < 2; ++k) dst[m][k] = *(const LAS bf16x8*)(lds + PG8_SA(b, h) + aoff + m * 2048 + k * 1024); } while (0)
#define PG8_LDB(dst, b, h) do { _Pragma("unroll") for (int n = 0; n < 2; ++n) _Pragma("unroll") for (int k = 0; k < 2; ++k) dst[n][k] = *(const LAS bf16x8*)(lds + PG8_SB(b, h) + boff + n * 2048 + k * 1024); } while (0)
#define PG8_MMA(ai, bj, At, Bt) do { __builtin_amdgcn_s_setprio(1); _Pragma("unroll") for (int m = 0; m < 4; ++m) _Pragma("unroll") for (int n = 0; n < 2; ++n) _Pragma("unroll") for (int k = 0; k < 2; ++k) \
        acc[ai][bj][m][n] = __builtin_amdgcn_mfma_f32_16x16x32_bf16(Bt[n][k], At[m][k], acc[ai][bj][m][n], 0, 0, 0); __builtin_amdgcn_s_setprio(0); } while (0)
#define PG8_WAIT_V(n) asm volatile("s_waitcnt vmcnt(" #n ")" ::: "memory")
#define PG8_WAIT_L(n) asm volatile("s_waitcnt lgkmcnt(" #n ")" ::: "memory")
#define PG8_BAR __builtin_amdgcn_s_barrier()
#define PG8_SCHED __builtin_amdgcn_sched_barrier(0)
    Unit cur, nxt; int ui = 0;
    if (!S.next(0, cur)) return;
    f32x4 acc[2][2][4][2];
#pragma unroll
    for (int a = 0; a < 2; ++a)
#pragma unroll
        for (int b = 0; b < 2; ++b)
#pragma unroll
            for (int m = 0; m < 4; ++m)
#pragma unroll
                for (int n = 0; n < 2; ++n) acc[a][b][m][n] = (f32x4){0.f, 0.f, 0.f, 0.f};
    bf16x8 At[4][2], B0[2][2], B1[2][2];
    const char* cA = (const char*)(cur.pz ? g.A2 : g.A) + (size_t)cur.pm * tstepA; const char* cB = (const char*)(cur.pz ? g.Bt2 : g.Bt) + (size_t)cur.pn * tstepB;
    {
        PG8_STAGE(PG8_SB(0, 0), cB, voffB); PG8_STAGE(PG8_SB(0, 1), cB + hstepB, voffB); PG8_STAGE(PG8_SA(0, 0), cA, voffA); PG8_STAGE(PG8_SA(0, 1), cA + hstepA, voffA);
        if (wr == 1) PG8_BAR;
        PG8_WAIT_V(2); PG8_BAR;
        PG8_STAGE(PG8_SB(1, 0), cB + kstep, voffB); PG8_STAGE(PG8_SA(1, 0), cA + kstep, voffA); PG8_STAGE(PG8_SB(1, 1), cB + hstepB + kstep, voffB);
        PG8_WAIT_V(6); PG8_BAR;
    }
    for (;;) {
        const bool has_next = S.next(ui + 1, nxt);
        const char* nA = has_next ? (const char*)(nxt.pz ? g.A2 : g.A) + (size_t)nxt.pm * tstepA : cA; const char* nB = has_next ? (const char*)(nxt.pz ? g.Bt2 : g.Bt) + (size_t)nxt.pn * tstepB : cB;
        for (int t = 0; t < nt; t += 2) {
            const bool last = (t == nt - 2);
            const char* a1 = cA + (size_t)(t + 1) * kstep;
            const char* a2 = last ? nA : cA + (size_t)(t + 2) * kstep; const char* b2 = last ? nB : cB + (size_t)(t + 2) * kstep;
            const char* a3 = a2 + kstep; const char* b3 = b2 + kstep;
            PG8_LDB(B0, 0, 0); PG8_LDB(B1, 0, 1); PG8_SCHED; PG8_LDA(At, 0, 0); PG8_STAGE(PG8_SA(1, 1), a1 + hstepA, voffA);
            PG8_WAIT_V(8); PG8_WAIT_L(0); PG8_BAR; PG8_MMA(0, 0, At, B0); PG8_MMA(0, 1, At, B1); PG8_BAR; PG8_SCHED;
            PG8_LDA(At, 0, 1); PG8_STAGE(PG8_SB(0, 0), b2, voffB); PG8_STAGE(PG8_SB(0, 1), b2 + hstepB, voffB); PG8_STAGE(PG8_SA(0, 0), a2, voffA);
            PG8_WAIT_V(8); PG8_WAIT_L(0); PG8_BAR; PG8_MMA(1, 0, At, B0); PG8_MMA(1, 1, At, B1); PG8_BAR; PG8_SCHED;
            PG8_LDB(B0, 1, 0); PG8_LDB(B1, 1, 1); PG8_SCHED; PG8_LDA(At, 1, 0); PG8_STAGE(PG8_SA(0, 1), a2 + hstepA, voffA);
            PG8_WAIT_V(8); PG8_WAIT_L(0); PG8_BAR; PG8_MMA(0, 0, At, B0); PG8_MMA(0, 1, At, B1); PG8_BAR; PG8_SCHED;
            PG8_LDA(At, 1, 1); PG8_STAGE(PG8_SB(1, 0), b3, voffB); PG8_STAGE(PG8_SB(1, 1), b3 + hstepB, voffB); PG8_STAGE(PG8_SA(1, 0), a3, voffA);
            PG8_WAIT_V(8); PG8_WAIT_L(0); PG8_BAR; PG8_MMA(1, 0, At, B0); PG8_MMA(1, 1, At, B1); PG8_BAR; PG8_SCHED;
        }
        if (wr == 0) PG8_BAR;
        E(acc, cur, wr, wc, fr, fq);
        if (!has_next) break;
#pragma unroll
        for (int a = 0; a < 2; ++a)
#pragma unroll
            for (int b = 0; b < 2; ++b)
#pragma unroll
                for (int m = 0; m < 4; ++m)
#pragma unroll
                    for (int n = 0; n < 2; ++n) acc[a][b][m][n] = (f32x4){0.f, 0.f, 0.f, 0.f};
        cur = nxt; cA = nA; cB = nB; ++ui;
        if (wr == 1) PG8_BAR;
    }
    PG8_WAIT_V(0);
    PG8_BAR;
#undef PG8_SA
#undef PG8_SB
#undef PG8_STAGE
#undef PG8_LDA
#undef PG8_LDB
#undef PG8_MMA
#undef PG8_WAIT_V
#undef PG8_WAIT_L
#undef PG8_BAR
#undef PG8_SCHED
}
}
using pg8::Unit;
typedef f32x4 Acc[2][2][4][2];

__device__ __forceinline__ void store_bf16x8(bf16_t* p, f32x4 v0, f32x4 v1) {
    u32x4 w; w.x = pk2(v0[0], v0[1]); w.y = pk2(v0[2], v0[3]); w.z = pk2(v1[0], v1[1]); w.w = pk2(v1[2], v1[3]);
    *(u32x4*)p = w;
}

struct EpiG1 {
    static constexpr int MIDK = 0;
    const float* bias; unsigned char* ws; float* out;
    __device__ __forceinline__ void operator()(const Acc& acc, const Unit& u, int wr, int wc, int fr, int fq) const {
        const int pn = u.pn;
        const int rowb = u.pm * 256 + wr * 64 + fr;
        const int cl = wc * 32 + 8 * fq;
        if (pn == 20) {
            if (wc != 0 || fq == 3) return;
            float* GA = (float*)(ws + WS_GA);
            float* lfb = (u.pm < 128) ? out + O_LFP : out + O_LFS - (size_t)MP * 8;
#pragma unroll
            for (int ai = 0; ai < 2; ++ai)
#pragma unroll
                for (int m = 0; m < 4; ++m) {
                    const int row = rowb + ai * 128 + m * 16;
                    f32x4 v0 = acc[ai][0][m][0] + *(const f32x4*)(bias + pn * 256 + cl), v1 = acc[ai][0][m][1] + *(const f32x4*)(bias + pn * 256 + cl + 4);
                    if (fq < 2) { float* p = GA + (unsigned)(row * 16 + 8 * fq); *(f32x4*)p = v0; *(f32x4*)(p + 4) = v1; }
                    else {
                        float* p = lfb + (unsigned)(row * 8);
                        f32x4 a, b;
#pragma unroll
                        for (int j = 0; j < 4; ++j) { a[j] = logsigf_(v0[j]); b[j] = logsigf_(v1[j]); }
                        *(f32x4*)p = a; *(f32x4*)(p + 4) = b;
                    }
                }
            return;
        }
        bf16_t* dst; int ld, c0, act = 0; float scale = 1.f; size_t fofsP = 0, fofsS = 0; bool f32out = false;
        if (pn == 0) { dst = (bf16_t*)(ws + WS_GQ); ld = 256; c0 = 0; scale = 0.125f; }
        else if (pn == 1) { dst = (bf16_t*)(ws + WS_GK); ld = 256; c0 = 0; }
        else if (pn < 4) { dst = (bf16_t*)(ws + WS_GV); ld = 512; c0 = (pn - 2) * 256; }
        else if (pn < 6) { dst = (bf16_t*)(ws + WS_GR); ld = 512; c0 = (pn - 4) * 256; act = 1; }
        else if (pn < 8) { dst = (bf16_t*)(ws + WS_FQ); ld = 512; c0 = (pn - 6) * 256; scale = C2; }
        else if (pn < 10) { dst = (bf16_t*)(ws + WS_FK); ld = 512; c0 = (pn - 8) * 256; f32out = true; fofsP = O_FKP; fofsS = O_FKS; }
        else if (pn < 12) { dst = (bf16_t*)(ws + WS_FV); ld = 512; c0 = (pn - 10) * 256; f32out = true; fofsP = O_FVP; fofsS = O_FVS; }
        else if (pn < 16) { dst = (bf16_t*)out; ld = 1024; c0 = (pn - 12) * 256; act = 2; }
        else { dst = (bf16_t*)out + (size_t)MT * 1024; ld = 1024; c0 = (pn - 16) * 256; act = 2; }
        float* fbase = (u.pm < 128) ? out + fofsP : out + fofsS - (size_t)MP * 512;
#pragma unroll
        for (int ai = 0; ai < 2; ++ai)
#pragma unroll
            for (int m = 0; m < 4; ++m) {
                const int row = rowb + ai * 128 + m * 16;
#pragma unroll
                for (int bj = 0; bj < 2; ++bj) {
                    f32x4 v0 = acc[ai][bj][m][0] + *(const f32x4*)(bias + pn * 256 + bj * 128 + cl), v1 = acc[ai][bj][m][1] + *(const f32x4*)(bias + pn * 256 + bj * 128 + cl + 4);
                    const int col = c0 + bj * 128 + cl;
                    if (f32out) {
                        float* p = fbase + (unsigned)(row * 512 + col);
                        *(f32x4*)p = v0; *(f32x4*)(p + 4) = v1;
                    }
                    if (act == 1) {
#pragma unroll
                        for (int j = 0; j < 4; ++j) { v0[j] = siluf_(v0[j]); v1[j] = siluf_(v1[j]); }
                    } else if (act == 2) {
#pragma unroll
                        for (int j = 0; j < 4; ++j) { v0[j] = sigmoidf_(v0[j]); v1[j] = sigmoidf_(v1[j]); }
                    } else { v0 = v0 * scale; v1 = v1 * scale; }
                    store_bf16x8(dst + (unsigned)(row * ld + col), v0, v1);
                }
                asm volatile("" ::: "memory");
            }
    }
};

struct EpiM {
    static constexpr int MIDK = 0;
    const bf16_t* ZG; const bf16_t* ZF; bf16_t* MB;
    __device__ __forceinline__ void operator()(const Acc& acc, const Unit& u, int wr, int wc, int fr, int fq) const {
        const int rowb = u.pm * 256 + wr * 64 + fr, colb = u.pn * 256 + wc * 32 + 8 * fq;
        const bf16_t* Z = u.pz ? ZF : ZG;
#pragma unroll
        for (int ai = 0; ai < 2; ++ai)
#pragma unroll
            for (int m = 0; m < 4; ++m) {
                const size_t ro = (size_t)(rowb + ai * 128 + m * 16) * 1024;
#pragma unroll
                for (int bj = 0; bj < 2; ++bj) {
                    const u32x4 f = *(const u32x4*)(Z + ro + colb + bj * 128);
                    f32x4 s0 = {bflo(f.x), bfhi(f.x), bflo(f.y), bfhi(f.y)}, s1 = {bflo(f.z), bfhi(f.z), bflo(f.w), bfhi(f.w)};
                    f32x4 v0 = acc[ai][bj][m][0] * s0, v1 = acc[ai][bj][m][1] * s1;
                    if (u.pz) { const u32x4 o = *(const u32x4*)(MB + ro + colb + bj * 128);
                        v0 = v0 + (f32x4){bflo(o.x), bfhi(o.x), bflo(o.y), bfhi(o.y)}; v1 = v1 + (f32x4){bflo(o.z), bfhi(o.z), bflo(o.w), bfhi(o.w)}; }
                    store_bf16x8(MB + ro + colb + bj * 128, v0, v1);
                }
            }
    }
};

__device__ __forceinline__ void row_partial(const f32x4 (&v)[4], float& mean, float& m2) {
    float s = 0.f;
#pragma unroll
    for (int i = 0; i < 4; ++i) s += (v[i][0] + v[i][1]) + (v[i][2] + v[i][3]);
    s += __shfl_xor(s, 16); s += __shfl_xor(s, 32);
    mean = s * (1.0f / 64.0f);
    float q = 0.f;
#pragma unroll
    for (int i = 0; i < 4; ++i) { const f32x4 d = v[i] - mean; q += (d[0] * d[0] + d[1] * d[1]) + (d[2] * d[2] + d[3] * d[3]); }
    q += __shfl_xor(q, 16); q += __shfl_xor(q, 32);
    m2 = q;
}

struct EpiOut {
    static constexpr int MIDK = 0;
    const float* xp; const float* xs; bf16_t* T1; f32x2* STP;
    __device__ __forceinline__ void operator()(const Acc& acc, const Unit& u, int wr, int wc, int fr, int fq) const {
        const int rowb = u.pm * 256 + wr * 64 + fr, colb = u.pn * 256 + wc * 32 + 8 * fq;
#pragma unroll
        for (int ai = 0; ai < 2; ++ai)
#pragma unroll
            for (int m = 0; m < 4; ++m) {
                const int row = rowb + ai * 128 + m * 16;
                const float* xr = (row < MP) ? xp + (size_t)row * 1024 : xs + (size_t)(row - MP) * 1024;
                f32x4 v[4];
#pragma unroll
                for (int bj = 0; bj < 2; ++bj) {
                    const f32x4 x0 = *(const f32x4*)(xr + colb + bj * 128), x1 = *(const f32x4*)(xr + colb + bj * 128 + 4);
                    v[2 * bj] = acc[ai][bj][m][0] + x0 * DN_ALPHA; v[2 * bj + 1] = acc[ai][bj][m][1] + x1 * DN_ALPHA;
                    store_bf16x8(T1 + (size_t)row * 1024 + colb + bj * 128, v[2 * bj], v[2 * bj + 1]);
                }
                float mean, m2; row_partial(v, mean, m2);
                if (fq == 0) STP[(size_t)row * 16 + u.pn * 4 + wc] = (f32x2){mean, m2};
            }
    }
};

struct EpiSwiglu {
    static constexpr int MIDK = 0;
    const f32x2* FST; const float* GW; const float* BW; bf16_t* AH;
    __device__ __forceinline__ void operator()(const Acc& acc, const Unit& u, int wr, int wc, int fr, int fq) const {
        const int rowb = u.pm * 256 + wr * 64 + fr, cl = wc * 32 + 8 * fq;
        f32x4 gwg[2], gwu[2], bwg[2], bwu[2];
#pragma unroll
        for (int n = 0; n < 2; ++n) {
            gwg[n] = *(const f32x4*)(GW + u.pn * 256 + cl + 4 * n); gwu[n] = *(const f32x4*)(GW + u.pn * 256 + 128 + cl + 4 * n);
            bwg[n] = *(const f32x4*)(BW + u.pn * 256 + cl + 4 * n); bwu[n] = *(const f32x4*)(BW + u.pn * 256 + 128 + cl + 4 * n);
        }
#pragma unroll
        for (int ai = 0; ai < 2; ++ai)
#pragma unroll
            for (int m = 0; m < 4; ++m) {
                const int row = rowb + ai * 128 + m * 16;
                const f32x2 st = FST[row];
                f32x4 o[2];
#pragma unroll
                for (int n = 0; n < 2; ++n) {
                    const f32x4 gg = (acc[ai][0][m][n] - gwg[n] * st.x) * st.y + bwg[n];
                    const f32x4 uu = (acc[ai][1][m][n] - gwu[n] * st.x) * st.y + bwu[n];
#pragma unroll
                    for (int j = 0; j < 4; ++j) o[n][j] = siluf_(gg[j]) * uu[j];
                }
                store_bf16x8(AH + (size_t)row * DFF + u.pn * 128 + cl, o[0], o[1]);
            }
    }
};

struct EpiDown {
    static constexpr int MIDK = 0;
    const bf16_t* T1; const f32x2* FST; const float* g1; const float* b1; float* Y; f32x2* STP;
    __device__ __forceinline__ void operator()(const Acc& acc, const Unit& u, int wr, int wc, int fr, int fq) const {
        const int rowb = u.pm * 256 + wr * 64 + fr, colb = u.pn * 256 + wc * 32 + 8 * fq;
        f32x4 gv[4], bv[4];
#pragma unroll
        for (int bj = 0; bj < 2; ++bj)
#pragma unroll
            for (int n = 0; n < 2; ++n) { gv[2 * bj + n] = *(const f32x4*)(g1 + colb + bj * 128 + 4 * n); bv[2 * bj + n] = *(const f32x4*)(b1 + colb + bj * 128 + 4 * n); }
#pragma unroll
        for (int ai = 0; ai < 2; ++ai)
#pragma unroll
            for (int m = 0; m < 4; ++m) {
                const int row = rowb + ai * 128 + m * 16;
                const f32x2 st = FST[row];
                f32x4 v[4];
#pragma unroll
                for (int bj = 0; bj < 2; ++bj) {
                    const u32x4 t = *(const u32x4*)(T1 + (size_t)row * 1024 + colb + bj * 128);
                    const f32x4 t0 = {bflo(t.x), bfhi(t.x), bflo(t.y), bfhi(t.y)}, t1 = {bflo(t.z), bfhi(t.z), bflo(t.w), bfhi(t.w)};
                    const f32x4 x0 = (t0 - st.x) * st.y * gv[2 * bj] + bv[2 * bj], x1 = (t1 - st.x) * st.y * gv[2 * bj + 1] + bv[2 * bj + 1];
                    v[2 * bj] = acc[ai][bj][m][0] + x0 * DN_ALPHA; v[2 * bj + 1] = acc[ai][bj][m][1] + x1 * DN_ALPHA;
                    float* p = Y + (size_t)row * 1024 + colb + bj * 128;
                    *(f32x4*)p = v[2 * bj]; *(f32x4*)(p + 4) = v[2 * bj + 1];
                }
                float mean, m2; row_partial(v, mean, m2);
                if (fq == 0) STP[(size_t)row * 16 + u.pn * 4 + wc] = (f32x2){mean, m2};
            }
    }
};


#define RLX_AGENT __ATOMIC_RELAXED, __HIP_MEMORY_SCOPE_AGENT
#define XB_TMO      128
#define XB_XCNT(j)  (256  + 64 * (j))
#define XB_XSUB(j)  (1280 + 64 * (j))
#define XB_XGEN(j)  (2304 + 64 * (j))
#define XB_TOP      3328
#define XB_TOPGEN   3392
#define XCD_BAR_WORDS 3456
#define XB_SPIN_CAP (1u << 18)

__device__ __forceinline__ unsigned xb_ld(unsigned* p)              { return __hip_atomic_load(p, __ATOMIC_RELAXED, __HIP_MEMORY_SCOPE_AGENT); }
__device__ __forceinline__ unsigned xb_add(unsigned* p, unsigned v) { return __hip_atomic_fetch_add(p, v, __ATOMIC_RELAXED, __HIP_MEMORY_SCOPE_AGENT); }
__device__ __forceinline__ unsigned xb_xcc_id() { return (unsigned)__builtin_amdgcn_s_getreg((3 << 11) | 20) & 0xFu; }
#define XB_SPIN(cond, bar) do { unsigned _sp = 0; while (cond) { __builtin_amdgcn_s_sleep(1); \
    if ((++_sp & 255u) == 0u) { if (xb_ld(&(bar)[XB_TMO])) break; if (_sp > XB_SPIN_CAP) { atomicAdd(&(bar)[XB_TMO], 1u); break; } } } } while (0)

struct XcdBarrier {
    unsigned* bar; unsigned x;
    volatile LAS unsigned* st;
};

__device__ __forceinline__ XcdBarrier xcd_barrier_post(unsigned* bar, volatile LAS unsigned* st) {
    XcdBarrier b; b.bar = bar; b.x = xb_xcc_id(); b.st = st;
    if (threadIdx.x == 0) (void)xb_add(&bar[XB_XCNT(b.x)], 1u);
    return b;
}
__device__ __forceinline__ void xcd_barrier_complete(unsigned* bar, unsigned x, unsigned& nloc, unsigned& nx) {
    const unsigned G = gridDim.x * gridDim.y * gridDim.z;
    unsigned sum, cnt, mine, sp = 0u;
    for (;;) {
        sum = 0u; cnt = 0u; mine = 0u;
#pragma unroll
        for (unsigned j = 0; j < 16; ++j) { const unsigned c = xb_ld(&bar[XB_XCNT(j)]); sum += c; cnt += (c > 0u) ? 1u : 0u; mine = (j == x) ? c : mine; }
        if (sum == G) break;
        __builtin_amdgcn_s_sleep(1);
        if ((++sp & 255u) == 0u) { if (xb_ld(&bar[XB_TMO])) break; if (sp > XB_SPIN_CAP) { atomicAdd(&bar[XB_TMO], 1u); break; } }
    }
    nloc = mine > 0u ? mine : 1u; nx = cnt > 0u ? cnt : 1u;
}

__device__ __forceinline__ void xcd_barrier(const XcdBarrier& b) {
    asm volatile("s_waitcnt vmcnt(0)" ::: "memory");
    __syncthreads();
    if (threadIdx.x == 0) {
        unsigned* bar = b.bar;
        __builtin_amdgcn_s_waitcnt(0);
        unsigned nloc = b.st[0], nx = b.st[1];
        if (nloc == 0u) { xcd_barrier_complete(bar, b.x, nloc, nx); b.st[0] = nloc; b.st[1] = nx; }
        const unsigned old = xb_add(&bar[XB_XSUB(b.x)], 1u);
        const unsigned gen = old / nloc;
        if (old + 1u == (gen + 1u) * nloc) {
            __builtin_amdgcn_fence(__ATOMIC_RELEASE, "agent");
            asm volatile("s_waitcnt vmcnt(0)" ::: "memory");
            const unsigned og = xb_add(&bar[XB_TOP], 1u);
            const unsigned tg = og / nx;
            if (og + 1u == (tg + 1u) * nx) xb_add(&bar[XB_TOPGEN], 1u);
            else XB_SPIN(xb_ld(&bar[XB_TOPGEN]) == tg, bar);
            __builtin_amdgcn_fence(__ATOMIC_ACQUIRE, "agent");
            xb_add(&bar[XB_XGEN(b.x)], 1u);
            asm volatile("s_waitcnt vmcnt(0)" ::: "memory");
        } else {
            XB_SPIN(xb_ld(&bar[XB_XGEN(b.x)]) == gen, bar);
            __builtin_amdgcn_fence(__ATOMIC_ACQUIRE, "agent");
            asm volatile("s_waitcnt vmcnt(0)" ::: "memory");
        }
    }
    __syncthreads();
}

__device__ __forceinline__ int win_src_col(int n) {
    if (n < 1024) return n;
    if (n < 3072) return n + 16;
    if (n < 5120) return n + 24;
    if (n < 5136) return 1024 + (n - 5120);
    if (n < 5144) return 3088 + (n - 5136);
    return -1;
}
__device__ __forceinline__ void transpose_item(const float* W, int ldw, int ksrc0, int scol0, bool winmap, bf16_t* WT, int ldt, int n0, int kdst0,
                                               const float* kscale, const float* bvec, float* bpart, LAS float* scr, int lane) {
    const int j = lane & 31;
    int sc = winmap ? win_src_col(n0 + j) : scol0 + j;
#pragma unroll 8
    for (int i = 0; i < 32; ++i) { const int kk = 2 * i + (lane >> 5); scr[kk * 33 + j] = (sc >= 0) ? W[(size_t)(ksrc0 + kk) * ldw + sc] : 0.f; }
    asm volatile("s_waitcnt lgkmcnt(0)" ::: "memory");
    if (bpart) {
        if (lane < 32) { float s = 0.f;
            for (int kk = 0; kk < 64; ++kk) s += bvec[ksrc0 + kk] * scr[kk * 33 + lane];
            bpart[n0 + lane] = s; }
    }
    const int c = lane & 7;
    float ks[8];
#pragma unroll
    for (int e = 0; e < 8; ++e) ks[e] = kscale ? kscale[ksrc0 + 8 * c + e] : 1.f;
#pragma unroll
    for (int jj = 0; jj < 4; ++jj) { const int n = (lane >> 3) + 8 * jj; const LAS float* s = scr + (8 * c) * 33 + n;
        u32x4 o; o.x = pk2(s[0 * 33] * ks[0], s[1 * 33] * ks[1]); o.y = pk2(s[2 * 33] * ks[2], s[3 * 33] * ks[3]); o.z = pk2(s[4 * 33] * ks[4], s[5 * 33] * ks[5]); o.w = pk2(s[6 * 33] * ks[6], s[7 * 33] * ks[7]);
        *(u32x4*)(WT + (size_t)(n0 + n) * ldt + kdst0 + 8 * c) = o; }
    asm volatile("s_waitcnt lgkmcnt(0)" ::: "memory");
}

__device__ __forceinline__ void phase0(const Params& p, LAS unsigned char* lds, int tid, int lane, int wave) {
    unsigned char* ws = PWS();
    const int G = gridDim.x, gw = blockIdx.x * 8 + wave, NGW = G * 8, gt = blockIdx.x * 512 + tid, NGT = G * 512;
    LAS float* scr = (LAS float*)(lds + wave * 16384);
    constexpr int I_WIN = 16 * (NIN / 32), I_WP = 2 * 8 * 32, I_WO = 16 * 32, I_WGU = 16 * 176, I_WD = 44 * 32;
    constexpr int NITEMS = I_WIN + I_WP + I_WO + I_WGU + I_WD;
    for (int it = gw; it < NITEMS; it += NGW) {
        int r = it;
        if (r < I_WIN) { const int kb = r / (NIN / 32), nb = r % (NIN / 32);
            transpose_item(PIN(6), 5144, 64 * kb, 0, true, (bf16_t*)(ws + WS_WIN), 1024, 32 * nb, 64 * kb, nullptr, nullptr, nullptr, scr, lane); continue; }
        r -= I_WIN;
        if (r < I_WP) { const int which = r / 256, rr = r % 256, kb = rr / 32, nb = rr % 32;
            transpose_item(which ? PIN(12) : PIN(11), 1024, 64 * kb, 32 * nb, false, (bf16_t*)(ws + WS_WP), 1024, 32 * nb, which * 512 + 64 * kb, nullptr, nullptr, nullptr, scr, lane); continue; }
        r -= I_WP;
        if (r < I_WO) { const int kb = r / 32, nb = r % 32;
            transpose_item(PIN(13), 1024, 64 * kb, 32 * nb, false, (bf16_t*)(ws + WS_WO), 1024, 32 * nb, 64 * kb, nullptr, nullptr, nullptr, scr, lane); continue; }
        r -= I_WO;
        if (r < I_WGU) { const int kb = r / 176, r32 = r % 176, pn = r32 / 8, wi = r32 % 8;
            const float* W = (wi < 4) ? PIN(16) : PIN(17); const int scol = 128 * pn + 32 * (wi & 3);
            transpose_item(W, DFF, 64 * kb, scol, false, (bf16_t*)(ws + WS_WGU), 1024, 32 * r32, 64 * kb, PIN(14), PIN(15), (float*)(ws + WS_VEC) + VO_BWP + kb * 5632, scr, lane); continue; }
        r -= I_WGU;
        { const int kb = r / 32, nb = r % 32;
            transpose_item(PIN(18), 1024, 64 * kb, 32 * nb, false, (bf16_t*)(ws + WS_WD), DFF, 32 * nb, 64 * kb, nullptr, nullptr, nullptr, scr, lane); }
    }
    for (int n = gt; n < NIN; n += NGT) { const int sc = win_src_col(n); ((float*)(ws + WS_VEC))[VO_BIAS + n] = sc >= 0 ? PIN(7)[sc] : 0.f; }
    bf16_t* XB = (bf16_t*)(ws + WS_R1);
    for (int m = gw; m < MT; m += NGW) {
        const float* xr = (m < MP) ? PIN(0) + (size_t)m * 1024 : PIN(1) + (size_t)(m - MP) * 1024;
        const f32x4* xv = (const f32x4*)xr + lane;
        u32x2* o = (u32x2*)(XB + (size_t)m * 1024) + lane;
#pragma unroll
        for (int j = 0; j < 4; ++j) { const f32x4 v = xv[64 * j]; o[64 * j] = (u32x2){pk2(v[0], v[1]), pk2(v[2], v[3])}; }
    }
    {
        float* KBLK = (float*)(ws + WS_CTL) + CW_KBLK;
        for (int idx = gt; idx < 16 * 2048 * 8; idx += NGT) {
            const int h = idx & 7, s = (idx >> 3) & 2047, b = idx >> 14;
            const f32x4* kp = (const f32x4*)(PIN(3) + ((size_t)(b * 2048 + s) * 8 + h) * 64);
            float ss = 0.f;
#pragma unroll
            for (int i = 0; i < 16; ++i) { const f32x4 v = kp[i]; ss += (v[0] * v[0] + v[1] * v[1]) + (v[2] * v[2] + v[3] * v[3]); }
            ss = fmaxf(ss, __shfl_xor(ss, 8)); ss = fmaxf(ss, __shfl_xor(ss, 16)); ss = fmaxf(ss, __shfl_xor(ss, 32));
            if (lane < 8) atomicMax((int*)(KBLK + ((2 + b) * 8 + h) * 128 + (s >> 7)), __float_as_int(ss));
        }
    }
    {
        float* CLOC = (float*)(ws + WS_CLOC); float* CTOT = (float*)(ws + WS_CTOT);
        for (int it = gw; it < 16 * 8 * 16; it += NGW) {
            const int blk = it & 15, h = (it >> 4) & 7, b = it >> 7;
            const float* lf = PIN(5) + ((size_t)b * 2048 + blk * 128) * 8 + h;
            const float v0 = lf[(2 * lane) * 8] * LOG2E, v1 = lf[(2 * lane + 1) * 8] * LOG2E;
            const float inc = wave_incl_scan(v0 + v1, lane), exc = inc - (v0 + v1);
            float* cl = CLOC + ((size_t)((2 + b) * 8 + h)) * 16384 + blk * 128;
            cl[2 * lane] = exc + v0; cl[2 * lane + 1] = inc;
            if (lane == 63) CTOT[((2 + b) * 8 + h) * 128 + blk] = inc;
        }
    }
}

constexpr int GLA_ITEMS = 2048 + 64;
__device__ __forceinline__ void gla_item_geom(int gi, int& row0, int& L, int& h, int& b) {
    if (gi < 2048) { const int bh = gi >> 8, c = gi & 255; b = bh >> 2; h = bh & 3; row0 = b * 16384 + c * 64; L = 64; }
    else { const int s = gi - 2048; b = s >> 2; h = s & 3; row0 = MP + b * 32; L = 32; }
}
constexpr int KD_STRIDE = 144, V_STRIDE = 272;
__device__ __forceinline__ void gla_pass1(int gi, const Params& p, LAS unsigned char* lds, int tid, int lane, int wave) {
    unsigned char* ws = PWS();
    int row0, L, h, b; gla_item_geom(gi, row0, L, h, b);
    LAS unsigned char* KD = lds; LAS unsigned char* VB = lds + 64 * KD_STRIDE;
    const int t = lane; const bool valid = t < L; const int row = row0 + (valid ? t : 0);
    const bf16_t* GQ = (const bf16_t*)(ws + WS_GQ); const bf16_t* GK = (const bf16_t*)(ws + WS_GK); const bf16_t* GV = (const bf16_t*)(ws + WS_GV);
    bf16_t* GQT = (bf16_t*)(ws + WS_GQT); bf16_t* GKT = (bf16_t*)(ws + WS_GKT);
    const float* GA = (const float*)(ws + WS_GA);
    f32x4 ga[4];
#pragma unroll
    for (int i = 0; i < 4; ++i) ga[i] = *(const f32x4*)(GA + (size_t)row * 16 + 4 * i);
    const int dcol = h * 64 + 8 * wave;
    float bc[8], bl[8];
#pragma unroll
    for (int i = 0; i < 8; ++i) {
        float z = PIN(9)[dcol + i];
#pragma unroll
        for (int j = 0; j < 16; ++j) z += ga[j >> 2][j & 3] * PIN(8)[j * 256 + dcol + i];
        const float la = valid ? logsigf_(z) * (1.0f / 16.0f) : 0.f;
        bc[i] = wave_incl_scan(la, lane);
        bl[i] = __shfl(bc[i], 63);
    }
    {
        const u32x4 qv = *(const u32x4*)(GQ + (size_t)row * 256 + dcol), kv = *(const u32x4*)(GK + (size_t)row * 256 + dcol);
        float q[8] = {bflo(qv.x), bfhi(qv.x), bflo(qv.y), bfhi(qv.y), bflo(qv.z), bfhi(qv.z), bflo(qv.w), bfhi(qv.w)};
        float k[8] = {bflo(kv.x), bfhi(kv.x), bflo(kv.y), bfhi(kv.y), bflo(kv.z), bfhi(kv.z), bflo(kv.w), bfhi(kv.w)};
        float qt[8], kt[8], kd[8];
#pragma unroll
        for (int i = 0; i < 8; ++i) { qt[i] = q[i] * __expf(bc[i]); kt[i] = k[i] * __expf(-bc[i]); kd[i] = valid ? k[i] * __expf(bl[i] - bc[i]) : 0.f; }
        if (valid) {
            *(u32x4*)(GQT + (size_t)row * 256 + dcol) = (u32x4){pk2(qt[0], qt[1]), pk2(qt[2], qt[3]), pk2(qt[4], qt[5]), pk2(qt[6], qt[7])};
            *(u32x4*)(GKT + (size_t)row * 256 + dcol) = (u32x4){pk2(kt[0], kt[1]), pk2(kt[2], kt[3]), pk2(kt[4], kt[5]), pk2(kt[6], kt[7])};
        }
        *(LAS u32x4*)(KD + t * KD_STRIDE + 16 * wave) = (u32x4){pk2(kd[0], kd[1]), pk2(kd[2], kd[3]), pk2(kd[4], kd[5]), pk2(kd[6], kd[7])};
        if (lane == 0) { float* DEC = (float*)(ws + WS_DEC) + (size_t)gi * 64 + 8 * wave;
#pragma unroll
            for (int i = 0; i < 8; ++i) DEC[i] = __expf(bl[i]); }
    }
#pragma unroll
    for (int j = 0; j < 2; ++j) { const int ci = tid + 512 * j, r = ci >> 4, c16 = ci & 15;
        u32x4 v = {0u, 0u, 0u, 0u};
        if (r < L) v = *(const u32x4*)(GV + (size_t)(row0 + r) * 512 + h * 128 + c16 * 8);
        *(LAS u32x4*)(VB + r * V_STRIDE + c16 * 16) = v; }
    __syncthreads();
    {
        const int g = lane >> 4, i16 = lane & 15, q = i16 >> 2, pp = i16 & 3;
        f32x4 acc[4];
#pragma unroll
        for (int mt = 0; mt < 4; ++mt) acc[mt] = (f32x4){0.f, 0.f, 0.f, 0.f};
#pragma unroll
        for (int ks = 0; ks < 2; ++ks) {
            const int r0 = 32 * ks + 8 * g + q;
            const bf16x8 bfrag = tr_read2(VB + r0 * V_STRIDE + (16 * wave + 4 * pp) * 2, VB + (r0 + 4) * V_STRIDE + (16 * wave + 4 * pp) * 2);
#pragma unroll
            for (int mt = 0; mt < 4; ++mt) {
                const bf16x8 afrag = tr_read2(KD + r0 * KD_STRIDE + (16 * mt + 4 * pp) * 2, KD + (r0 + 4) * KD_STRIDE + (16 * mt + 4 * pp) * 2);
                acc[mt] = __builtin_amdgcn_mfma_f32_16x16x32_bf16(afrag, bfrag, acc[mt], 0, 0, 0);
            }
        }
        float* U = (float*)(ws + WS_R1) + (size_t)gi * 8192;
#pragma unroll
        for (int mt = 0; mt < 4; ++mt)
#pragma unroll
            for (int i = 0; i < 4; ++i) U[(16 * mt + 4 * g + i) * 128 + 16 * wave + i16] = acc[mt][i];
    }
    __syncthreads();
}

__device__ __forceinline__ void phase2(const Params& p, LAS unsigned char* lds, int tid, int lane, int wave) {
    unsigned char* ws = PWS();
    const int G = gridDim.x, gw = blockIdx.x * 8 + wave, NGW = G * 8, gt = blockIdx.x * 512 + tid, NGT = G * 512;
    for (int gi = blockIdx.x; gi < GLA_ITEMS; gi += G) gla_pass1(gi, p, lds, tid, lane, wave);
    {
        float* QMAX = (float*)(ws + WS_CTL) + CW_QMAX; float* KBLK = (float*)(ws + WS_CTL) + CW_KBLK;
        const bf16_t* FQ = (const bf16_t*)(ws + WS_FQ); const bf16_t* FK = (const bf16_t*)(ws + WS_FK);
        for (int idx = gt; idx < 2 * MT * 8; idx += NGT) {
            const int which = idx >= MT * 8, rem = which ? idx - MT * 8 : idx, h = rem & 7, m = rem >> 3;
            const u32x4* src = (const u32x4*)((which ? FK : FQ) + (size_t)m * 512 + h * 64);
            float ss = 0.f;
#pragma unroll
            for (int i = 0; i < 8; ++i) { const u32x4 v = src[i];
                const float a0 = bflo(v.x), a1 = bfhi(v.x), a2 = bflo(v.y), a3 = bfhi(v.y), a4 = bflo(v.z), a5 = bfhi(v.z), a6 = bflo(v.w), a7 = bfhi(v.w);
                ss += (a0 * a0 + a1 * a1) + (a2 * a2 + a3 * a3) + (a4 * a4 + a5 * a5) + (a6 * a6 + a7 * a7); }
            ss = fmaxf(ss, __shfl_xor(ss, 8)); ss = fmaxf(ss, __shfl_xor(ss, 16)); ss = fmaxf(ss, __shfl_xor(ss, 32));
            if (lane < 8) {
                float* dst;
                if (!which) dst = QMAX + ((m < MP) ? (m >> 7) : 256 + ((m - MP) >> 5)) * 8 + h;
                else dst = (m < MP) ? KBLK + ((m >> 14) * 8 + h) * 128 + ((m & 16383) >> 7) : KBLK + ((2 + ((m - MP) >> 5)) * 8 + h) * 128 + 16;
                atomicMax((int*)dst, __float_as_int(ss));
            }
        }
    }
    {
        float* CLOC = (float*)(ws + WS_CLOC); float* CTOT = (float*)(ws + WS_CTOT);
        for (int it = gw; it < 2048 + 128; it += NGW) {
            if (it < 2048) {
                const int blk = it & 127, h = (it >> 7) & 7, b = it >> 10;
                const float* lf = POUT() + O_LFP + ((size_t)b * 16384 + blk * 128) * 8 + h;
                const float v0 = lf[(2 * lane) * 8] * LOG2E, v1 = lf[(2 * lane + 1) * 8] * LOG2E;
                const float inc = wave_incl_scan(v0 + v1, lane), exc = inc - (v0 + v1);
                float* cl = CLOC + ((size_t)(b * 8 + h)) * 16384 + blk * 128;
                cl[2 * lane] = exc + v0; cl[2 * lane + 1] = inc;
                if (lane == 63) CTOT[(b * 8 + h) * 128 + blk] = inc;
            } else {
                const int s = it - 2048, h = s & 7, b = s >> 3;
                const float* lf = POUT() + O_LFS + ((size_t)b * 32) * 8 + h;
                const float v0 = lane < 32 ? lf[lane * 8] * LOG2E : 0.f;
                const float inc = wave_incl_scan(v0, lane);
                float* cl = CLOC + ((size_t)((2 + b) * 8 + h)) * 16384 + 2048;
                if (lane < 32) cl[lane] = inc;
                if (lane == 63) CTOT[((2 + b) * 8 + h) * 128 + 16] = inc;
            }
        }
    }
}

__device__ __forceinline__ void gla_scan(const Params& p, int lane, int wave) {
    unsigned char* ws = PWS();
    const int G = gridDim.x, gw = blockIdx.x * 8 + wave, NGW = G * 8;
    const float* U = (const float*)(ws + WS_R1); const float* DEC = (const float*)(ws + WS_DEC);
    bf16_t* SP = (bf16_t*)(ws + WS_R4);
    for (int it = gw; it < 1024; it += NGW) {
        const int bh = it >> 7, e = (it & 127) * 64 + lane, i = e >> 7;
        float s = 0.f;
        const float* up = U + (size_t)bh * 256 * 8192 + e; const float* dp = DEC + (size_t)bh * 256 * 64 + i; bf16_t* sp = SP + (size_t)bh * 256 * 8192 + e;
        for (int c0 = 0; c0 < 256; c0 += 16) {
            float uu[16], dd[16];
#pragma unroll
            for (int c = 0; c < 16; ++c) { uu[c] = up[(size_t)(c0 + c) * 8192]; dd[c] = dp[(c0 + c) * 64]; }
#pragma unroll
            for (int c = 0; c < 16; ++c) { sp[(size_t)(c0 + c) * 8192] = (bf16_t)(pk2(s, 0.f) & 0xffffu); s = dd[c] * s + uu[c]; }
        }
        POUT()[O_GSP + (size_t)bh * 8192 + e] = s;
    }
    for (int it = gw; it < 64 * 128; it += NGW) {
        const int sh = it >> 7, e = (it & 127) * 64 + lane, i = e >> 7;
        const float s0 = PIN(2)[(size_t)sh * 8192 + e];
        POUT()[O_GSS + (size_t)sh * 8192 + e] = DEC[(size_t)(2048 + sh) * 64 + i] * s0 + U[(size_t)(2048 + sh) * 8192 + e];
    }
}

constexpr int FOX_UNITS = 2048 + 128;
constexpr int AK_STRIDE = 144;
__device__ __forceinline__ void fox_unit(int ui, const Params& p, LAS unsigned char* lds, int tid, int lane, int wave) {
    unsigned char* ws = PWS();
    const bool samp = ui >= 2048;
    int b, h, I, seq, qrow0, nq, qb, krow0;
    if (!samp) { b = ui >> 10; h = (ui >> 7) & 7; I = 127 - (ui & 127); seq = b; qrow0 = b * 16384 + I * 128; nq = 128; qb = b * 128 + I; krow0 = b * 16384; }
    else { const int s = ui - 2048; b = s >> 3; h = s & 7; seq = 2 + b; I = 16; qrow0 = MP + b * 32; nq = 32; qb = 256 + b; krow0 = MP + b * 32; }
    LAS unsigned char* KL = lds; LAS unsigned char* VL = lds + 128 * AK_STRIDE; LAS float* CK = (LAS float*)(lds + 2 * 128 * AK_STRIDE);
    const bf16_t* FQ = (const bf16_t*)(ws + WS_FQ); const bf16_t* FK = (const bf16_t*)(ws + WS_FK); const bf16_t* FV = (const bf16_t*)(ws + WS_FV);
    const float* CLOC = (const float*)(ws + WS_CLOC) + (size_t)(seq * 8 + h) * 16384;
    const float* CTOT = (const float*)(ws + WS_CTOT) + (seq * 8 + h) * 128;
    const float* KBLK = (const float*)(ws + WS_CTL) + CW_KBLK + (seq * 8 + h) * 128;
    const int g = lane >> 4, i16 = lane & 15, tq = i16 >> 2, pp = i16 & 3;
    const int qi = 16 * wave + i16;
    const bool qvalid = qi < nq;
    const bool wvalid = 16 * wave < nq;
    int J0;
    {
        const float qmax = sqrtf(((const float*)(ws + WS_CTL))[CW_QMAX + qb * 8 + h]);
        float kg = 0.f;
        { float a = (lane <= I) ? KBLK[lane] : 0.f; float c = (lane + 64 <= I) ? KBLK[lane + 64] : 0.f; a = fmaxf(a, c);
#pragma unroll
          for (int o = 1; o < 64; o <<= 1) a = fmaxf(a, __shfl_xor(a, o));
          kg = sqrtf(a); }
        const float base = qmax * kg + qmax * sqrtf(KBLK[I]);
        int J = I - 1; float Dsum = 0.f;
        while (J >= 0 && !(base + Dsum < -THR2)) { Dsum += CTOT[J]; --J; }
        J0 = J + 1;
    }
    bf16x8 qf[2];
    float cq2 = 0.f;
    {
        const bf16_t* qp = FQ + (size_t)(qrow0 + (qvalid ? qi : 0)) * 512 + h * 64 + 8 * g;
        qf[0] = *(const bf16x8*)qp; qf[1] = *(const bf16x8*)(qp + 32);
        cq2 = CLOC[(samp ? 2048 : I * 128) + (qvalid ? qi : 0)];
    }
    float mrun = -1e30f, lpart = 0.f;
    f32x4 o[4];
#pragma unroll
    for (int dt = 0; dt < 4; ++dt) o[dt] = (f32x4){0.f, 0.f, 0.f, 0.f};
    float dlt = 0.f;
    for (int J = I; J >= J0; --J) {
        if (J < I) dlt += CTOT[J];
        __syncthreads();
#pragma unroll
        for (int j = 0; j < 2; ++j) {
            const int ci = tid + 512 * j, r = ci >> 3, c16 = ci & 7;
            u32x4 kv = {0u, 0u, 0u, 0u}, vv = {0u, 0u, 0u, 0u};
            if (!samp) {
                const size_t go = (size_t)(krow0 + J * 128 + r) * 512 + h * 64 + c16 * 8;
                kv = *(const u32x4*)(FK + go); vv = *(const u32x4*)(FV + go);
            } else if (J == 16) {
                if (r < 32) { const size_t go = (size_t)(krow0 + r) * 512 + h * 64 + c16 * 8; kv = *(const u32x4*)(FK + go); vv = *(const u32x4*)(FV + go); }
            } else {
                const size_t go = ((size_t)(b * 2048 + J * 128 + r) * 8 + h) * 64 + c16 * 8;
                const f32x4 k0 = *(const f32x4*)(PIN(3) + go), k1 = *(const f32x4*)(PIN(3) + go + 4), v0 = *(const f32x4*)(PIN(4) + go), v1 = *(const f32x4*)(PIN(4) + go + 4);
                kv = (u32x4){pk2(k0[0], k0[1]), pk2(k0[2], k0[3]), pk2(k1[0], k1[1]), pk2(k1[2], k1[3])};
                vv = (u32x4){pk2(v0[0], v0[1]), pk2(v0[2], v0[3]), pk2(v1[0], v1[1]), pk2(v1[2], v1[3])};
            }
            *(LAS u32x4*)(KL + r * AK_STRIDE + c16 * 16) = kv; *(LAS u32x4*)(VL + r * AK_STRIDE + c16 * 16) = vv;
        }
        if (tid < 128) CK[tid] = (samp && J == 16 && tid >= 32) ? 0.f : CLOC[J * 128 + tid];
        __syncthreads();
        if (!wvalid) continue;
        f32x4 s[8];
        const float cqe = cq2 + dlt;
#pragma unroll
        for (int kt = 0; kt < 8; ++kt) {
            const f32x4 ck = *(const LAS f32x4*)(CK + 16 * kt + 4 * g);
            f32x4 c = {cqe - ck[0], cqe - ck[1], cqe - ck[2], cqe - ck[3]};
            const bf16x8 k0 = *(const LAS bf16x8*)(KL + (16 * kt + i16) * AK_STRIDE + 16 * g);
            const bf16x8 k1 = *(const LAS bf16x8*)(KL + (16 * kt + i16) * AK_STRIDE + 64 + 16 * g);
            c = __builtin_amdgcn_mfma_f32_16x16x32_bf16(k0, qf[0], c, 0, 0, 0);
            c = __builtin_amdgcn_mfma_f32_16x16x32_bf16(k1, qf[1], c, 0, 0, 0);
            s[kt] = c;
        }
        if (J == I) {
#pragma unroll
            for (int kt = 0; kt < 8; ++kt)
#pragma unroll
                for (int i = 0; i < 4; ++i) if (16 * kt + 4 * g + i > qi) s[kt][i] = -1e30f;
        }
        float mt = -1e30f;
#pragma unroll
        for (int kt = 0; kt < 8; ++kt) mt = fmaxf(mt, fmaxf(fmaxf(s[kt][0], s[kt][1]), fmaxf(s[kt][2], s[kt][3])));
        mt = fmaxf(mt, __shfl_xor(mt, 16)); mt = fmaxf(mt, __shfl_xor(mt, 32));
        const float mnew = fmaxf(mrun, mt);
        const float alpha = exp2f(mrun - mnew);
        mrun = mnew;
        float ps = 0.f;
#pragma unroll
        for (int kt = 0; kt < 8; ++kt)
#pragma unroll
            for (int i = 0; i < 4; ++i) { const float e = exp2f(s[kt][i] - mnew); s[kt][i] = e; ps += e; }
        lpart = lpart * alpha + ps;
#pragma unroll
        for (int dt = 0; dt < 4; ++dt) o[dt] = o[dt] * alpha;
#pragma unroll
        for (int kk = 0; kk < 4; ++kk) {
            const bf16x8 pf = pack8(s[2 * kk], s[2 * kk + 1]);
            const int r0 = 32 * kk + 4 * g + tq;
#pragma unroll
            for (int dt = 0; dt < 4; ++dt) {
                const bf16x8 vf = tr_read2(VL + r0 * AK_STRIDE + (16 * dt + 4 * pp) * 2, VL + (r0 + 16) * AK_STRIDE + (16 * dt + 4 * pp) * 2);
                o[dt] = __builtin_amdgcn_mfma_f32_16x16x32_bf16(vf, pf, o[dt], 0, 0, 0);
            }
        }
    }
    if (wvalid) {
        float l = lpart; l += __shfl_xor(l, 16); l += __shfl_xor(l, 32);
        const float inv = 1.0f / l;
        if (qvalid) {
            bf16_t* op = (bf16_t*)(ws + WS_OGF) + (size_t)(qrow0 + qi) * 1024 + 512 + h * 64 + 4 * g;
#pragma unroll
            for (int dt = 0; dt < 4; ++dt) *(u32x2*)(op + 16 * dt) = (u32x2){pk2(o[dt][0] * inv, o[dt][1] * inv), pk2(o[dt][2] * inv, o[dt][3] * inv)};
        }
    }
}

__device__ __forceinline__ void phase3(const Params& p, LAS unsigned char* lds, int tid, int lane, int wave, int rep_) {
    gla_scan(p, lane, wave);
    unsigned* ctr = (unsigned*)(PWS() + WS_CTL) + CW_ACTR + rep_;
    LAS int* slot = (LAS int*)(lds + 131072);
    for (;;) {
        __syncthreads();
        if (tid == 0) slot[0] = (int)atomicAdd(ctr, 1u);
        __syncthreads();
        const int ui = slot[0];
        if (ui >= FOX_UNITS) break;
        fox_unit(ui, p, lds, tid, lane, wave);
    }
}

__device__ __forceinline__ void gla_pass3(int gi, const Params& p, LAS unsigned char* lds, int tid, int lane, int wave) {
    unsigned char* ws = PWS();
    int row0, L, h, b; gla_item_geom(gi, row0, L, h, b);
    LAS unsigned char* QT = lds; LAS unsigned char* KT = lds + 64 * KD_STRIDE; LAS unsigned char* VB = lds + 2 * 64 * KD_STRIDE; LAS unsigned char* SB = VB + 64 * V_STRIDE;
    LAS float* SSQ = (LAS float*)(SB + 64 * V_STRIDE);
    const bf16_t* GQ = (const bf16_t*)(ws + WS_GQT); const bf16_t* GK = (const bf16_t*)(ws + WS_GKT); const bf16_t* GV = (const bf16_t*)(ws + WS_GV);
    __syncthreads();
    { const int r = tid >> 3, c16 = tid & 7;
        u32x4 qv = {0u, 0u, 0u, 0u}, kv = {0u, 0u, 0u, 0u};
        if (r < L) { qv = *(const u32x4*)(GQ + (size_t)(row0 + r) * 256 + h * 64 + c16 * 8); kv = *(const u32x4*)(GK + (size_t)(row0 + r) * 256 + h * 64 + c16 * 8); }
        *(LAS u32x4*)(QT + r * KD_STRIDE + c16 * 16) = qv; *(LAS u32x4*)(KT + r * KD_STRIDE + c16 * 16) = kv; }
#pragma unroll
    for (int j = 0; j < 2; ++j) { const int ci = tid + 512 * j, r = ci >> 4, c16 = ci & 15;
        u32x4 v = {0u, 0u, 0u, 0u}, sv;
        if (r < L) v = *(const u32x4*)(GV + (size_t)(row0 + r) * 512 + h * 128 + c16 * 8);
        *(LAS u32x4*)(VB + r * V_STRIDE + c16 * 16) = v;
        if (gi < 2048) sv = *(const u32x4*)((const bf16_t*)(ws + WS_R4) + (size_t)gi * 8192 + r * 128 + c16 * 8);
        else { const float* sp = PIN(2) + (size_t)(gi - 2048) * 8192 + r * 128 + c16 * 8; const f32x4 a = *(const f32x4*)sp, c = *(const f32x4*)(sp + 4);
            sv = (u32x4){pk2(a[0], a[1]), pk2(a[2], a[3]), pk2(c[0], c[1]), pk2(c[2], c[3])}; }
        *(LAS u32x4*)(SB + r * V_STRIDE + c16 * 16) = sv; }
    __syncthreads();
    const int g = lane >> 4, i16 = lane & 15, tq = i16 >> 2, pp = i16 & 3;
    const int tt = wave & 3, dh = wave >> 2;
    bf16x8 qf[2];
    qf[0] = *(const LAS bf16x8*)(QT + (16 * tt + i16) * KD_STRIDE + 16 * g); qf[1] = *(const LAS bf16x8*)(QT + (16 * tt + i16) * KD_STRIDE + 64 + 16 * g);
    f32x4 at[4];
#pragma unroll
    for (int st = 0; st < 4; ++st) {
        f32x4 c = {0.f, 0.f, 0.f, 0.f};
        if (st <= tt) {
            const bf16x8 k0 = *(const LAS bf16x8*)(KT + (16 * st + i16) * KD_STRIDE + 16 * g), k1 = *(const LAS bf16x8*)(KT + (16 * st + i16) * KD_STRIDE + 64 + 16 * g);
            c = __builtin_amdgcn_mfma_f32_16x16x32_bf16(k0, qf[0], c, 0, 0, 0);
            c = __builtin_amdgcn_mfma_f32_16x16x32_bf16(k1, qf[1], c, 0, 0, 0);
            if (st == tt) {
#pragma unroll
                for (int i = 0; i < 4; ++i) if (4 * g + i > i16) c[i] = 0.f;
            }
        }
        at[st] = c;
    }
    bf16x8 pf[2]; pf[0] = pack8(at[0], at[1]); pf[1] = pack8(at[2], at[3]);
    f32x4 o[4]; float ssq = 0.f;
#pragma unroll
    for (int dl = 0; dl < 4; ++dl) {
        const int dt = 4 * dh + dl;
        f32x4 c = {0.f, 0.f, 0.f, 0.f};
#pragma unroll
        for (int ks = 0; ks < 2; ++ks) {
            const int r0 = 32 * ks + 4 * g + tq;
            const bf16x8 vf = tr_read2(VB + r0 * V_STRIDE + (16 * dt + 4 * pp) * 2, VB + (r0 + 16) * V_STRIDE + (16 * dt + 4 * pp) * 2);
            c = __builtin_amdgcn_mfma_f32_16x16x32_bf16(vf, pf[ks], c, 0, 0, 0);
            const int r1 = 32 * ks + 8 * g + tq;
            const bf16x8 sf = tr_read2(SB + r1 * V_STRIDE + (16 * dt + 4 * pp) * 2, SB + (r1 + 4) * V_STRIDE + (16 * dt + 4 * pp) * 2);
            c = __builtin_amdgcn_mfma_f32_16x16x32_bf16(sf, qf[ks], c, 0, 0, 0);
        }
        o[dl] = c; ssq += (c[0] * c[0] + c[1] * c[1]) + (c[2] * c[2] + c[3] * c[3]);
    }
    ssq += __shfl_xor(ssq, 16); ssq += __shfl_xor(ssq, 32);
    if (g == 0) SSQ[dh * 64 + 16 * tt + i16] = ssq;
    __syncthreads();
    const int t = 16 * tt + i16;
    const float rstd = rsqrtf((SSQ[t] + SSQ[64 + t]) * (1.0f / 128.0f) + 1e-5f);
    if (t < L) {
        const bf16_t* GR = (const bf16_t*)(ws + WS_GR) + (size_t)(row0 + t) * 512 + h * 128;
        bf16_t* OG = (bf16_t*)(ws + WS_OGF) + (size_t)(row0 + t) * 1024 + h * 128;
#pragma unroll
        for (int dl = 0; dl < 4; ++dl) {
            const int dv = 16 * (4 * dh + dl) + 4 * g;
            const u32x2 gr = *(const u32x2*)(GR + dv);
            const f32x4 gn = *(const f32x4*)(PIN(10) + h * 128 + dv);
            const float v0 = o[dl][0] * rstd * gn[0] * bflo(gr.x), v1 = o[dl][1] * rstd * gn[1] * bfhi(gr.x), v2 = o[dl][2] * rstd * gn[2] * bflo(gr.y), v3 = o[dl][3] * rstd * gn[3] * bfhi(gr.y);
            *(u32x2*)(OG + dv) = (u32x2){pk2(v0, v1), pk2(v2, v3)};
        }
    }
}

__device__ __forceinline__ void phase_stats1(const Params& p, int tid, int lane, int wave) {
    unsigned char* ws = PWS();
    const int G = gridDim.x, gw = blockIdx.x * 8 + wave, NGW = G * 8, gt = blockIdx.x * 512 + tid, NGT = G * 512;
    const f32x2* STP = (const f32x2*)(ws + WS_STP1); f32x2* FST = (f32x2*)(ws + WS_FST1);
    for (int r = gt; r < MT; r += NGT) {
        f32x2 pt[16]; float ms = 0.f;
#pragma unroll
        for (int i = 0; i < 16; ++i) { pt[i] = STP[(size_t)r * 16 + i]; ms += pt[i].x; }
        const float mean = ms * (1.0f / 16.0f); float q = 0.f;
#pragma unroll
        for (int i = 0; i < 16; ++i) { const float d = pt[i].x - mean; q += pt[i].y + 64.0f * d * d; }
        FST[r] = (f32x2){mean, rsqrtf(q * (1.0f / 1024.0f) + 1e-5f)};
    }
    float* vec = (float*)(ws + WS_VEC);
    const bf16_t* WGU = (const bf16_t*)(ws + WS_WGU);
    for (int c = gw; c < 5632; c += NGW) {
        const u32x4* rp = (const u32x4*)(WGU + (size_t)c * 1024) + lane * 2;
        float s = 0.f;
#pragma unroll
        for (int i = 0; i < 2; ++i) { const u32x4 v = rp[i]; s += (bflo(v.x) + bfhi(v.x)) + (bflo(v.y) + bfhi(v.y)) + (bflo(v.z) + bfhi(v.z)) + (bflo(v.w) + bfhi(v.w)); }
#pragma unroll
        for (int o = 1; o < 64; o <<= 1) s += __shfl_xor(s, o);
        if (lane == 0) vec[VO_GW + c] = s;
    }
    for (int c = gt; c < 5632; c += NGT) { float s = 0.f;
#pragma unroll
        for (int kb = 0; kb < 16; ++kb) s += vec[VO_BWP + kb * 5632 + c];
        vec[VO_BW + c] = s; }
}

__device__ __forceinline__ void phase_final_ln(const Params& p, int lane, int wave) {
    unsigned char* ws = PWS();
    const int G = gridDim.x, gw = blockIdx.x * 8 + wave, NGW = G * 8;
    const f32x2* STP = (const f32x2*)(ws + WS_STP2);
    for (int r = gw; r < MT; r += NGW) {
        const f32x2 pt = STP[(size_t)r * 16 + (lane & 15)];
        float ms = pt.x;
        ms += __shfl_xor(ms, 1); ms += __shfl_xor(ms, 2); ms += __shfl_xor(ms, 4); ms += __shfl_xor(ms, 8);
        const float mean = ms * (1.0f / 16.0f);
        const float d = pt.x - mean; float q = pt.y + 64.0f * d * d;
        q += __shfl_xor(q, 1); q += __shfl_xor(q, 2); q += __shfl_xor(q, 4); q += __shfl_xor(q, 8);
        const float rstd = rsqrtf(q * (1.0f / 1024.0f) + 1e-5f);
        f32x4* y = (f32x4*)(POUT() + (size_t)r * 1024) + lane;
        const f32x4* gg = (const f32x4*)PIN(19) + lane; const f32x4* bb = (const f32x4*)PIN(20) + lane;
#pragma unroll
        for (int j = 0; j < 4; ++j) { const f32x4 v = y[64 * j]; y[64 * j] = (v - mean) * rstd * gg[64 * j] + bb[64 * j]; }
    }
}

__global__ void __launch_bounds__(512, 2) fwd_megakernel(Params p) {
    extern __shared__ __attribute__((aligned(16))) unsigned char lds_raw[];
    LAS unsigned char* lds = (LAS unsigned char*)lds_raw;
    cg::grid_group grid = cg::this_grid();
    if (threadIdx.x < 4) ((LAS unsigned*)(lds + 131072 + 64))[threadIdx.x] = 0u;
    __syncthreads();
    const XcdBarrier xbar = xcd_barrier_post((unsigned*)(PWS() + WS_CTL) + CW_BAR, (volatile LAS unsigned*)(lds + 131072 + 64));
    if (gridDim.x == 0x7fffffu) grid.sync();
#define GSYNC() xcd_barrier(xbar)
#define TLW int tid_ = threadIdx.x; asm volatile("" : "+v"(tid_)); const int tid = tid_, lane = tid & 63, wave = __builtin_amdgcn_readfirstlane(tid >> 6); (void)lane; (void)wave

#ifndef SKIP_P0
    for (int rep_ = 0; rep_ < DUP_P0; ++rep_) { TLW; phase0(p, lds, tid, lane, wave); }
#endif
    GSYNC();
#ifndef SKIP_P1
    {
        unsigned char* ws = PWS(); const int G = gridDim.x;
        pg8::Gemm g{(const bf16_t*)(ws + WS_R1), (const bf16_t*)(ws + WS_WIN), MT, NIN, 1024, 1024, 1024, nullptr, nullptr}; pg8::StaticOrder S; S.init(MT, NIN, G, (int)blockIdx.x);
        EpiG1 E{(const float*)(ws + WS_VEC) + VO_BIAS, ws, POUT()};
        for (int rep_ = 0; rep_ < DUP_EPIG1; ++rep_) pg8::gemm_phase<EpiG1>(lds, g, S, E);
    }
#endif
    GSYNC();
#ifndef SKIP_P2
    for (int rep_ = 0; rep_ < DUP_P2; ++rep_) { TLW; phase2(p, lds, tid, lane, wave); }
#endif
    GSYNC();
#ifndef SKIP_P3
    for (int rep_ = 0; rep_ < DUP_P3; ++rep_) { TLW; phase3(p, lds, tid, lane, wave, rep_); if (rep_ + 1 < DUP_P3) GSYNC(); }
#endif
    GSYNC();
#ifndef SKIP_P4
    for (int rep_ = 0; rep_ < DUP_P4; ++rep_) { TLW; for (int gi = blockIdx.x; gi < GLA_ITEMS; gi += (int)gridDim.x) gla_pass3(gi, p, lds, tid, lane, wave); }
#endif
    GSYNC();
#ifndef SKIP_P5
    {
        unsigned char* ws = PWS(); const int G = gridDim.x;
        pg8::Gemm g{(const bf16_t*)(ws + WS_OGF), (const bf16_t*)(ws + WS_WP), MT, 1024, 512, 1024, 1024, (const bf16_t*)(ws + WS_OGF) + 512, (const bf16_t*)(ws + WS_WP) + 512}; pg8::StaticOrder S; S.init(MT, 1024, G, (int)blockIdx.x, 1);
        EpiM E{(const bf16_t*)POUT(), (const bf16_t*)POUT() + (size_t)MT * 1024, (bf16_t*)(ws + WS_R1)};
        for (int rep_ = 0; rep_ < DUP_EPIM; ++rep_) pg8::gemm_phase<EpiM>(lds, g, S, E);
    }
#endif
    GSYNC();
#ifndef SKIP_P6
    {
        unsigned char* ws = PWS(); const int G = gridDim.x;
        pg8::Gemm g{(const bf16_t*)(ws + WS_R1), (const bf16_t*)(ws + WS_WO), MT, 1024, 1024, 1024, 1024, nullptr, nullptr}; pg8::StaticOrder S; S.init(MT, 1024, G, (int)blockIdx.x);
        EpiOut E{PIN(0), PIN(1), (bf16_t*)(ws + WS_R2), (f32x2*)(ws + WS_STP1)};
        for (int rep_ = 0; rep_ < DUP_EPIOUT; ++rep_) pg8::gemm_phase<EpiOut>(lds, g, S, E);
    }
#endif
    GSYNC();
#ifndef SKIP_P6B
    { TLW; phase_stats1(p, tid, lane, wave); }
#endif
    GSYNC();
#ifndef SKIP_P7
    {
        unsigned char* ws = PWS(); const int G = gridDim.x;
        pg8::Gemm g{(const bf16_t*)(ws + WS_R2), (const bf16_t*)(ws + WS_WGU), MT, 5632, 1024, 1024, 1024, nullptr, nullptr}; pg8::StaticOrder S; S.init(MT, 5632, G, (int)blockIdx.x);
        EpiSwiglu E{(const f32x2*)(ws + WS_FST1), (const float*)(ws + WS_VEC) + VO_GW, (const float*)(ws + WS_VEC) + VO_BW, (bf16_t*)(ws + WS_R3)};
        for (int rep_ = 0; rep_ < DUP_EPISWIGLU; ++rep_) pg8::gemm_phase<EpiSwiglu>(lds, g, S, E);
    }
#endif
    GSYNC();
#ifndef SKIP_P8
    {
        unsigned char* ws = PWS(); const int G = gridDim.x;
        pg8::Gemm g{(const bf16_t*)(ws + WS_R3), (const bf16_t*)(ws + WS_WD), MT, 1024, DFF, DFF, DFF, nullptr, nullptr}; pg8::StaticOrder S; S.init(MT, 1024, G, (int)blockIdx.x);
        EpiDown E{(const bf16_t*)(ws + WS_R2), (const f32x2*)(ws + WS_FST1), PIN(14), PIN(15), POUT(), (f32x2*)(ws + WS_STP2)};
        for (int rep_ = 0; rep_ < DUP_EPIDOWN; ++rep_) pg8::gemm_phase<EpiDown>(lds, g, S, E);
    }
#endif
    GSYNC();
#ifndef SKIP_P9
    { TLW; phase_final_ln(p, lane, wave); }
#endif
}

extern "C" void kernel_launch(void* const* d_in, const int* in_sizes, int n_in, void* d_out, int out_size, void* d_ws, size_t ws_size, hipStream_t stream) {
    static int grid_blocks = 0;
    if (grid_blocks == 0) {
        if (n_in != 21 || ws_size < WS_END) { fprintf(stderr, "kernel_launch: unexpected n_in %d / ws_size %zu\n", n_in, ws_size); grid_blocks = -1; return; }
        int dev = 0, cus = 0, per_cu = 0;
        hipGetDevice(&dev);
        hipDeviceGetAttribute(&cus, hipDeviceAttributeMultiprocessorCount, dev);
        hipFuncSetAttribute((const void*)fwd_megakernel, hipFuncAttributeMaxDynamicSharedMemorySize, LDS_BYTES);
        hipOccupancyMaxActiveBlocksPerMultiprocessor(&per_cu, (const void*)fwd_megakernel, 512, LDS_BYTES);
        if (per_cu < 1) { fprintf(stderr, "kernel_launch: occupancy query returned %d\n", per_cu); per_cu = 1; }
        grid_blocks = cus * 1;
        (void)hipGetLastError();
    }
    if (grid_blocks < 0) return;
    hipMemsetAsync((char*)d_ws + WS_CTL, 0, CTL_BYTES, stream);
    Params p{};
    for (int i = 0; i < 21; ++i) p.in[i] = (const float*)d_in[i];
    p.out = (float*)d_out; p.ws = (unsigned char*)d_ws;
    void* args[] = {&p};
    hipError_t e = hipLaunchCooperativeKernel((const void*)fwd_megakernel, dim3(grid_blocks), dim3(512), args, LDS_BYTES, stream);
    if (e != hipSuccess) fprintf(stderr, "cooperative launch failed: %s (grid %d)\n", hipGetErrorString(e), grid_blocks);
}
```
